# Optimizing an MI355X kernel written in HIP

```python
import math
import jax
import jax.numpy as jnp
from jax import lax
import numpy as np

D_MODEL = 2048
BATCH = 4
SEQ = 2048
DEPTH = 1
DEC_BATCH = 128
DEC_SEQ = 1
PAST_LEN = 16384
PAGE_SIZE = 128

D_MIX = 2 * D_MODEL
D_A = D_MIX // 2
HA_DK = 128
HA_DV = 128
H_A = D_A // HA_DK
D_B = D_MIX - D_A
B_HEADDIM = 64
H_B = D_B // B_HEADDIM
B_NGROUPS = 8
HEADS_PER_GROUP = H_B // B_NGROUPS
B_DSTATE = 128
CONV_W = 4
CONV_DIM = D_B + 2 * B_NGROUPS * B_DSTATE
D_IN_PROJ = 4 * D_A + D_B + CONV_DIM + H_B
D_FF = 4 * D_MODEL
N_MOD = 6
CHUNK_A = 16
CHUNK_B = 64
EPS = 1e-6

kernel_name = 'hymba_hgrn2_mamba2_sandwich_adaln_step'


def _rms(x):
    xf = x.astype(jnp.float32)
    return (xf * lax.rsqrt(jnp.mean(xf * xf, axis=-1, keepdims=True) + EPS)).astype(x.dtype)


def _pad_time(a, n_pad):
    return jnp.pad(a, [(0, 0), (0, n_pad)] + [(0, 0)] * (a.ndim - 2))


def _to_chunks(a, chunk):
    b, t = a.shape[:2]
    return jnp.moveaxis(a.reshape((b, t // chunk, chunk) + a.shape[2:]), 1, 0)


def _from_chunks(a, t):
    a = jnp.moveaxis(a, 0, 1)
    return a.reshape((a.shape[0], a.shape[1] * a.shape[2]) + a.shape[3:])[:, :t]


def hgrn2_recurrence(q, log_f, k, v, s0):
    t = q.shape[1]
    chunk = min(CHUNK_A, t)
    n_pad = (-t) % chunk
    q, log_f, k, v = [_to_chunks(_pad_time(a.astype(jnp.float32), n_pad), chunk) for a in (q, log_f, k, v)]
    causal = jnp.tril(jnp.ones((chunk, chunk), dtype=bool))

    def step(s, inp):
        qc, lfc, kc, vc = inp
        b = jnp.cumsum(lfc, axis=1)
        qg = qc * jnp.exp(b)
        kg = kc * jnp.exp(-b)
        scores = jnp.where(causal, jnp.einsum('bthk,bshk->bhts', qg, kg), 0.0)
        o = jnp.einsum('bhts,bshv->bthv', scores, vc) + jnp.einsum('bthk,bhkv->bthv', qg, s)
        b_end = b[:, -1]
        k_end = kc * jnp.exp(b_end[:, None] - b)
        s_new = jnp.exp(b_end)[..., None] * s + jnp.einsum('bshk,bshv->bhkv', k_end, vc)
        return s_new, o

    s_fin, o = lax.scan(step, s0.astype(jnp.float32), (q, log_f, k, v))
    return _from_chunks(o, t), s_fin


def ssd_recurrence(x, dt, a, b_in, c_in, h0):
    t = x.shape[1]
    chunk = min(CHUNK_B, t)
    n_pad = (-t) % chunk
    x, dt, b_in, c_in = [_to_chunks(_pad_time(u.astype(jnp.float32), n_pad), chunk) for u in (x, dt, b_in, c_in)]
    causal = jnp.tril(jnp.ones((chunk, chunk), dtype=bool))

    def step(h, inp):
        xc, dtc, bc, cc = inp
        bh = jnp.repeat(bc, HEADS_PER_GROUP, axis=2)
        ch = jnp.repeat(cc, HEADS_PER_GROUP, axis=2)
        cum = jnp.cumsum(dtc * a, axis=1)
        seg = cum[:, :, None, :] - cum[:, None, :, :]
        decay = jnp.exp(jnp.where(causal[None, :, :, None], seg, -jnp.inf))
        scores = jnp.einsum('bthn,bshn->btsh', ch, bh) * decay * dtc[:, None, :, :]
        y = (jnp.einsum('btsh,bshp->bthp', scores, xc)
             + jnp.einsum('bthn,bhpn->bthp', ch, h) * jnp.exp(cum)[..., None])
        w_end = jnp.exp(cum[:, -1:] - cum) * dtc
        h_new = (jnp.exp(cum[:, -1])[:, :, None, None] * h
                 + jnp.einsum('bshn,bshp->bhpn', bh * w_end[..., None], xc))
        return h_new, y

    h_fin, y = lax.scan(step, h0.astype(jnp.float32), (x, dt, b_in, c_in))
    return _from_chunks(y, t), h_fin


def causal_conv(u, buf, w, b):
    t = u.shape[1]
    full = jnp.concatenate([buf.astype(u.dtype), u], axis=1)
    out = b
    for i in range(CONV_W):
        out = out + full[:, i:i + t] * w[i]
    return jax.nn.silu(out), full[:, full.shape[1] - (CONV_W - 1):]


def _layer(x, c, s_hgrn, s_ssm, s_conv, w_ada, b_ada, g_pre_mix, g_post_mix, g_pre_mlp, g_post_mlp,
           w_in, lb, hgrn_norm, conv_w, conv_b, dt_bias, a_log, d_skip, ssd_norm, w_out, w_up, w_down):
    bsz, t, _ = x.shape
    mod = jnp.einsum('bd,de->be', jax.nn.silu(c), w_ada) + b_ada
    sh1, sc1, gt1, sh2, sc2, gt2 = jnp.split(mod[:, None, :], N_MOD, axis=-1)

    h = _rms(x) * g_pre_mix * (1 + sc1) + sh1
    proj = jnp.einsum('btd,de->bte', h, w_in)
    bounds = np.cumsum([D_A, D_A, D_A, D_A, D_B, CONV_DIM]).tolist()
    q, f_logit, i_in, g_out, z, xbc, dt_raw = jnp.split(proj, bounds, axis=-1)

    f = lb + (1.0 - lb) * jax.nn.sigmoid(f_logit.astype(jnp.float32))
    qa = jax.nn.silu(q).reshape(bsz, t, H_A, HA_DK)
    log_f = jnp.log(f).reshape(bsz, t, H_A, HA_DK)
    ka = (1.0 - f).reshape(bsz, t, H_A, HA_DK)
    va = i_in.reshape(bsz, t, H_A, HA_DV)
    o_a, s_hgrn_new = hgrn2_recurrence(qa, log_f, ka, va, s_hgrn)
    o_a = _rms(o_a.astype(x.dtype)).reshape(bsz, t, D_A) * hgrn_norm * jax.nn.silu(g_out)

    xbc, s_conv_new = causal_conv(xbc, s_conv, conv_w, conv_b)
    xs, b_in, c_in = jnp.split(xbc, [D_B, D_B + B_NGROUPS * B_DSTATE], axis=-1)
    xs = xs.reshape(bsz, t, H_B, B_HEADDIM)
    dt = jax.nn.softplus(dt_raw.astype(jnp.float32) + dt_bias)
    a = -jnp.exp(a_log.astype(jnp.float32))
    y, s_ssm_new = ssd_recurrence(xs, dt, a, b_in.reshape(bsz, t, B_NGROUPS, B_DSTATE),
                                  c_in.reshape(bsz, t, B_NGROUPS, B_DSTATE), s_ssm)
    y = (y.astype(x.dtype) + d_skip[:, None] * xs).reshape(bsz, t, D_B)
    yz = (y * jax.nn.silu(z)).reshape(bsz, t, B_NGROUPS, D_B // B_NGROUPS)
    o_b = _rms(yz).reshape(bsz, t, D_B) * ssd_norm

    mix = jnp.einsum('bte,ed->btd', jnp.concatenate([o_a, o_b], axis=-1), w_out)
    x = x + gt1 * (_rms(mix) * g_post_mix)

    h = _rms(x) * g_pre_mlp * (1 + sc2) + sh2
    m = jnp.einsum('btf,fd->btd', jnp.square(jax.nn.relu(jnp.einsum('btd,df->btf', h, w_up))), w_down)
    x = x + gt2 * (_rms(m) * g_post_mlp)
    return x, s_hgrn_new.astype(x.dtype), s_ssm_new.astype(x.dtype), s_conv_new


def setup_inputs(seed: int = 0) -> dict:
    key = jax.random.key(seed)
    ks = jax.random.split(key, 28)
    f32 = jnp.float32

    def nrm(k, shape, scale):
        return jax.random.normal(k, shape, f32) * scale

    dt0 = jnp.exp(jax.random.uniform(ks[18], (DEPTH, H_B), f32, math.log(1e-3), math.log(1e-1)))
    return {
        'x_prompt': nrm(ks[0], (BATCH, SEQ, D_MODEL), 1.0),
        'x_sample': nrm(ks[1], (DEC_BATCH, DEC_SEQ, D_MODEL), 1.0),
        'c_prompt': nrm(ks[2], (BATCH, D_MODEL), 1.0),
        'c_sample': nrm(ks[3], (DEC_BATCH, D_MODEL), 1.0),
        'state_hgrn': nrm(ks[4], (DEPTH, DEC_BATCH, H_A, HA_DK, HA_DV), 0.3),
        'state_ssm': nrm(ks[5], (DEPTH, DEC_BATCH, H_B, B_HEADDIM, B_DSTATE), 0.1),
        'state_conv': nrm(ks[6], (DEPTH, DEC_BATCH, CONV_W - 1, CONV_DIM), 1.0),
        'w_ada': nrm(ks[7], (DEPTH, D_MODEL, N_MOD * D_MODEL), 0.5 * D_MODEL ** -0.5),
        'b_ada': nrm(ks[8], (DEPTH, N_MOD * D_MODEL), 0.02),
        'norm_pre_mix': 1.0 + nrm(ks[9], (DEPTH, D_MODEL), 0.02),
        'norm_post_mix': 1.0 + nrm(ks[10], (DEPTH, D_MODEL), 0.02),
        'norm_pre_mlp': 1.0 + nrm(ks[11], (DEPTH, D_MODEL), 0.02),
        'norm_post_mlp': 1.0 + nrm(ks[12], (DEPTH, D_MODEL), 0.02),
        'w_in': nrm(ks[13], (DEPTH, D_MODEL, D_IN_PROJ), D_MODEL ** -0.5),
        'hgrn_lb_logits': nrm(ks[14], (DEPTH + 1, D_A), 0.1),
        'hgrn_norm': 1.0 + nrm(ks[15], (DEPTH, D_A), 0.02),
        'conv_w': nrm(ks[16], (DEPTH, CONV_W, CONV_DIM), CONV_W ** -0.5),
        'conv_b': nrm(ks[17], (DEPTH, CONV_DIM), 0.02),
        'dt_bias': dt0 + jnp.log(-jnp.expm1(-dt0)),
        'a_log': jnp.log(jax.random.uniform(ks[19], (DEPTH, H_B), f32, 1.0, 16.0)),
        'd_skip': 1.0 + nrm(ks[20], (DEPTH, H_B), 0.1),
        'ssd_norm': 1.0 + nrm(ks[21], (DEPTH, D_B), 0.02),
        'w_out': nrm(ks[22], (DEPTH, D_MIX, D_MODEL), D_MIX ** -0.5),
        'w_up': nrm(ks[23], (DEPTH, D_MODEL, D_FF), D_MODEL ** -0.5),
        'w_down': nrm(ks[24], (DEPTH, D_FF, D_MODEL), D_FF ** -0.5),
    }


def reference(x_prompt, x_sample, c_prompt, c_sample, state_hgrn, state_ssm, state_conv,
              w_ada, b_ada, norm_pre_mix, norm_post_mix, norm_pre_mlp, norm_post_mlp,
              w_in, hgrn_lb_logits, hgrn_norm, conv_w, conv_b, dt_bias, a_log, d_skip, ssd_norm,
              w_out, w_up, w_down):
    lb_all = jnp.cumsum(jax.nn.softmax(hgrn_lb_logits.astype(jnp.float32), axis=0), axis=0)
    dtp = x_prompt.dtype
    zero_hgrn = jnp.zeros((BATCH, H_A, HA_DK, HA_DV), dtp)
    zero_ssm = jnp.zeros((BATCH, H_B, B_HEADDIM, B_DSTATE), dtp)
    zero_conv = jnp.zeros((BATCH, CONV_W - 1, CONV_DIM), dtp)
    xp, xs = x_prompt, x_sample
    hp_l, sp_l, cp_l, hs_l, ss_l, cs_l = [], [], [], [], [], []
    for l in range(DEPTH):
        lp = (w_ada[l], b_ada[l], norm_pre_mix[l], norm_post_mix[l], norm_pre_mlp[l], norm_post_mlp[l],
              w_in[l], lb_all[l], hgrn_norm[l], conv_w[l], conv_b[l], dt_bias[l], a_log[l], d_skip[l],
              ssd_norm[l], w_out[l], w_up[l], w_down[l])
        xp, hp, sp, cp = _layer(xp, c_prompt, zero_hgrn, zero_ssm, zero_conv, *lp)
        xs, hs, ss, cs = _layer(xs, c_sample, state_hgrn[l], state_ssm[l], state_conv[l], *lp)
        hp_l.append(hp); sp_l.append(sp); cp_l.append(cp)
        hs_l.append(hs); ss_l.append(ss); cs_l.append(cs)
    return (xp, xs, jnp.stack(hp_l), jnp.stack(sp_l), jnp.stack(cp_l),
            jnp.stack(hs_l), jnp.stack(ss_l), jnp.stack(cs_l))
```

```cpp
#include <hip/hip_runtime.h>
#include <cstdio>
#include <cstdint>

#ifndef MK_N_LAUNCHES
#define MK_N_LAUNCHES 1
#endif

namespace pg8 {
#define PG8_LAS __attribute__((address_space(3)))
typedef unsigned short bf16_t;
typedef short bf16x8 __attribute__((ext_vector_type(8)));
typedef float f32x4 __attribute__((ext_vector_type(4)));
typedef unsigned u32x4 __attribute__((ext_vector_type(4)));
constexpr int BM = 256, BK = 64, HALF = 128, HTB = HALF * BK * 2, STAGE_BYTES = 8 * HTB, NXCD = 8, WGM = 8;

__host__ __device__ __forceinline__ int lds_byte(int r, int c) { const int st = (r >> 4) * 2 + (c >> 5), rr = r & 15, cc = c & 31, ob = rr * 64 + cc * 2; return st * 1024 + (ob ^ (((ob >> 9) & 1) << 5)); }
__host__ __device__ __forceinline__ void stage_rc(int b, int& R, int& C) { const int st = b / 1024, sb = b % 1024, swz = sb ^ (((sb >> 9) & 1) << 5); R = (st >> 1) * 16 + swz / 64; C = (st & 1) * 32 + (swz % 64) / 2; }
__host__ __device__ __forceinline__ int perm32(int rho) { const int n = rho >> 4, i = rho & 15; return 8 * (i >> 2) + 4 * n + (i & 3); }

struct Unit { int pm, pn, ks; };
struct Gemm { const bf16_t* A; const bf16_t* Bt; int K, nt; };

struct FullOrder {
    int nM, nN, nwg, G, c;
    __device__ void init(int nM_, int nN_, int G_, int c_) { nM = nM_; nN = nN_; nwg = nM * nN; G = G_; c = c_; }
    __device__ bool next(int i, Unit& u) const {
        const long L = (long)i * G + c; if (L >= nwg) return false;
        int wgid = (int)L; { const int q = nwg / NXCD, r = nwg % NXCD, xcd = wgid % NXCD, off = wgid / NXCD; wgid = (xcd < r ? xcd * (q + 1) : r * (q + 1) + (xcd - r) * q) + off; }
        const int nig = WGM * nN, gid = wgid / nig, fm = gid * WGM, gsz = (nM - fm) < WGM ? (nM - fm) : WGM;
        u.pm = fm + ((wgid % nig) % gsz); u.pn = (wgid % nig) / gsz; u.ks = 0; return true;
    }
};
struct SplitOrder {
    int n_a, pn_a, n_b, pm_b, lks, G, c;
    __device__ bool next(int i, Unit& u) const {
        const int L = i * G + c; const int mask = (1 << lks) - 1;
        if (L < n_a) { u.pm = L >> lks; u.pn = pn_a; u.ks = L & mask; return true; }
        const int v = L - n_a; if (v >= n_b) return false;
        u.pm = pm_b; u.pn = v >> lks; u.ks = v & mask; return true;
    }
};

__device__ __forceinline__ unsigned cvt_pk_bf16(float lo, float hi) { unsigned r; asm volatile("v_cvt_pk_bf16_f32 %0, %1, %2" : "=v"(r) : "v"(lo), "v"(hi)); return r; }

template <int ACT  > struct EpiBf16 {
    static constexpr bool PERM = true;
    bf16_t* O; int ldc;
    __device__ __forceinline__ void operator()(const f32x4 (&acc)[2][2][4][2], const Unit& u, int wr, int wc, int fr, int fq) const {
        const int row0 = u.pm * BM + wr * 64 + fr, col0 = u.pn * BM + wc * 32 + 8 * fq;
#pragma unroll
        for (int ai = 0; ai < 2; ++ai)
#pragma unroll
            for (int m = 0; m < 4; ++m) { bf16_t* rowp = O + (size_t)(row0 + ai * HALF + m * 16) * ldc + col0;
#pragma unroll
                for (int bj = 0; bj < 2; ++bj) { f32x4 v0 = acc[ai][bj][m][0], v1 = acc[ai][bj][m][1];
                    if (ACT == 2) {
#pragma unroll
                        for (int e = 0; e < 4; ++e) { const float a = fmaxf(v0[e], 0.f), b = fmaxf(v1[e], 0.f); v0[e] = a * a; v1[e] = b * b; } }
                    u32x4 w; w.x = cvt_pk_bf16(v0[0], v0[1]); w.y = cvt_pk_bf16(v0[2], v0[3]); w.z = cvt_pk_bf16(v1[0], v1[1]); w.w = cvt_pk_bf16(v1[2], v1[3]);
                    *(u32x4*)(rowp + bj * HALF) = w; } }
    }
};
struct EpiF32 {
    static constexpr bool PERM = false;
    float* C; int ldc;
    __device__ __forceinline__ void operator()(const f32x4 (&acc)[2][2][4][2], const Unit& u, int wr, int wc, int fr, int fq) const {
        const int row0 = u.pm * BM + wr * 64 + fr, col0 = u.pn * BM + wc * 32 + 4 * fq;
#pragma unroll
        for (int ai = 0; ai < 2; ++ai)
#pragma unroll
            for (int m = 0; m < 4; ++m) { float* rowp = C + (size_t)(row0 + ai * HALF + m * 16) * ldc + col0;
#pragma unroll
                for (int bj = 0; bj < 2; ++bj)
#pragma unroll
                    for (int n = 0; n < 2; ++n) *(f32x4*)(rowp + bj * HALF + n * 16) = acc[ai][bj][m][n]; }
    }
};
struct EpiSlab {
    static constexpr bool PERM = false;
    float* Sb; int ld_b; int pm_b; float* Sa; int rows_a;
    __device__ __forceinline__ void operator()(const f32x4 (&acc)[2][2][4][2], const Unit& u, int wr, int wc, int fr, int fq) const {
        if (u.pm == pm_b) {
            const int col0 = u.pn * BM + wc * 32 + 4 * fq;
#pragma unroll
            for (int m = 0; m < 4; ++m) { float* rowp = Sb + ((size_t)u.ks * 128 + (wr * 64 + m * 16 + fr)) * ld_b + col0;
#pragma unroll
                for (int bj = 0; bj < 2; ++bj)
#pragma unroll
                    for (int n = 0; n < 2; ++n) *(f32x4*)(rowp + bj * HALF + n * 16) = acc[0][bj][m][n]; }
        } else if (wc == 0) {
#pragma unroll
            for (int ai = 0; ai < 2; ++ai)
#pragma unroll
                for (int m = 0; m < 4; ++m) { float* rowp = Sa + ((size_t)u.ks * rows_a + (u.pm * BM + ai * HALF + wr * 64 + m * 16 + fr)) * 32 + 4 * fq;
#pragma unroll
                    for (int n = 0; n < 2; ++n) *(f32x4*)(rowp + n * 16) = acc[ai][0][m][n]; }
        }
    }
};

template <class Epi, class Sched, bool ALIGN_EPI = false, bool SP2 = false>
__device__ __forceinline__ void gemm_phase(PG8_LAS unsigned char* lds, const Gemm g, const Sched& S, const Epi& E) {
    int tid_o = threadIdx.x; asm volatile("" : "+v"(tid_o));
    const int tid = tid_o, wid = __builtin_amdgcn_readfirstlane(tid >> 6), lane = tid & 63, wr = wid >> 2, wc = wid & 3, fr = lane & 15, fq = lane >> 4;
    const int K = g.K, nt = g.nt;
    unsigned voffA[2], voffB[2];
#pragma unroll
    for (int i = 0; i < 2; ++i) { int R, C; stage_rc(tid * 16 + i * 8192, R, C); const int Rb = Epi::PERM ? ((R & ~31) + perm32(R & 31)) : R;
        voffA[i] = (unsigned)(R * K + C) * 2u; voffB[i] = (unsigned)(Rb * K + C) * 2u; }
    const size_t kstep = (size_t)(BK * 2);
    const size_t hstep = (size_t)HALF * K * 2;
    const size_t tstep = 2 * hstep;
    const size_t sstep = (size_t)nt * kstep;
    const unsigned ldsw = (unsigned)wid * 1024u;
    const int aoff = lds_byte(wr * 64 + fr, fq * 8), boff = lds_byte(wc * 32 + fr, fq * 8);
#define PG8_SA(b, h) (((b) * 2 + (h)) * HTB)
#define PG8_SB(b, h) ((4 + (b) * 2 + (h)) * HTB)
#define PG8_STAGE(bufoff, gbase, voff) do { _Pragma("unroll") for (int _i = 0; _i < 2; ++_i) \
        __builtin_amdgcn_global_load_lds((const unsigned*)((const char*)(gbase) + (voff)[_i]), (PG8_LAS unsigned*)(lds + (bufoff) + ldsw + _i * 8192), 16, 0, 0); } while (0)
#define PG8_LDA(dst, b, h) do { _Pragma("unroll") for (int m = 0; m < 4; ++m) _Pragma("unroll") for (int k = 0; k < 2; ++k) dst[m][k] = *(const PG8_LAS bf16x8*)(lds + PG8_SA(b, h) + aoff + m * 2048 + k * 1024); } while (0)
#define PG8_LDB(dst, b, h) do { _Pragma("unroll") for (int n = 0; n < 2; ++n) _Pragma("unroll") for (int k = 0; k < 2; ++k) dst[n][k] = *(const PG8_LAS bf16x8*)(lds + PG8_SB(b, h) + boff + n * 2048 + k * 1024); } while (0)
#define PG8_MMA(ai, bj, At, Bt) do { __builtin_amdgcn_s_setprio(1); _Pragma("unroll") for (int m = 0; m < 4; ++m) _Pragma("unroll") for (int n = 0; n < 2; ++n) _Pragma("unroll") for (int k = 0; k < 2; ++k) \
        acc[ai][bj][m][n] = __builtin_amdgcn_mfma_f32_16x16x32_bf16(Bt[n][k], At[m][k], acc[ai][bj][m][n], 0, 0, 0); __builtin_amdgcn_s_setprio(0); } while (0)
#define PG8_WAIT_V(n) asm volatile("s_waitcnt vmcnt(" #n ")" ::: "memory")
#define PG8_WAIT_L(n) asm volatile("s_waitcnt lgkmcnt(" #n ")" ::: "memory")
#define PG8_BAR __builtin_amdgcn_s_barrier()
#define PG8_SCHED __builtin_amdgcn_sched_barrier(0)
    Unit cur, nxt; int ui = 0;
    if (!S.next(0, cur)) return;
    f32x4 acc[2][2][4][2];
#pragma unroll
    for (int a = 0; a < 2; ++a)
#pragma unroll
        for (int b = 0; b < 2; ++b)
#pragma unroll
            for (int m = 0; m < 4; ++m)
#pragma unroll
                for (int n = 0; n < 2; ++n) acc[a][b][m][n] = (f32x4){0.f, 0.f, 0.f, 0.f};
    bf16x8 At[4][2], B0[2][2], B1[2][2];
    const char* cA = (const char*)g.A + (size_t)cur.pm * tstep + (size_t)cur.ks * sstep; const char* cB = (const char*)g.Bt + (size_t)cur.pn * tstep + (size_t)cur.ks * sstep;
    if constexpr (SP2) {
        PG8_STAGE(PG8_SB(0, 0), cB, voffB); PG8_STAGE(PG8_SB(0, 1), cB + hstep, voffB); PG8_STAGE(PG8_SA(0, 0), cA, voffA); PG8_STAGE(PG8_SA(0, 1), cA + hstep, voffA);
        if (wr == 1) PG8_BAR;
        PG8_WAIT_V(2); PG8_BAR;
        PG8_STAGE(PG8_SB(1, 0), cB + kstep, voffB); PG8_STAGE(PG8_SA(1, 0), cA + kstep, voffA); PG8_STAGE(PG8_SB(1, 1), cB + hstep + kstep, voffB);
        PG8_WAIT_V(6); PG8_BAR;
    } else {
        PG8_STAGE(PG8_SB(0, 0), cB, voffB); PG8_STAGE(PG8_SA(0, 0), cA, voffA); PG8_STAGE(PG8_SB(0, 1), cB + hstep, voffB); PG8_STAGE(PG8_SA(0, 1), cA + hstep, voffA);
        if (wr == 1) PG8_BAR;
        PG8_WAIT_V(4); PG8_BAR;
        PG8_STAGE(PG8_SB(1, 0), cB + kstep, voffB); PG8_STAGE(PG8_SA(1, 0), cA + kstep, voffA); PG8_STAGE(PG8_SB(1, 1), cB + hstep + kstep, voffB);
        PG8_WAIT_V(6); PG8_BAR;
    }
    for (;;) {
        const bool has_next = S.next(ui + 1, nxt);
        const char* nA = has_next ? (const char*)g.A + (size_t)nxt.pm * tstep + (size_t)nxt.ks * sstep : cA; const char* nB = has_next ? (const char*)g.Bt + (size_t)nxt.pn * tstep + (size_t)nxt.ks * sstep : cB;
        for (int t = 0; t < nt; t += 2) {
            const bool last = (t == nt - 2);
            const char* a1 = cA + (size_t)(t + 1) * kstep;
            const char* a2 = last ? nA : cA + (size_t)(t + 2) * kstep; const char* b2 = last ? nB : cB + (size_t)(t + 2) * kstep;
            const char* a3 = a2 + kstep; const char* b3 = b2 + kstep;
            if constexpr (SP2) {
            PG8_LDB(B0, 0, 0); PG8_LDB(B1, 0, 1); PG8_SCHED; PG8_LDA(At, 0, 0); PG8_STAGE(PG8_SA(1, 1), a1 + hstep, voffA);
            PG8_WAIT_V(8); PG8_WAIT_L(0); PG8_BAR; PG8_MMA(0, 0, At, B0); PG8_MMA(0, 1, At, B1); PG8_BAR; PG8_SCHED;
            PG8_LDA(At, 0, 1); PG8_STAGE(PG8_SB(0, 0), b2, voffB); PG8_STAGE(PG8_SB(0, 1), b2 + hstep, voffB); PG8_STAGE(PG8_SA(0, 0), a2, voffA);
            PG8_WAIT_V(8); PG8_WAIT_L(0); PG8_BAR; PG8_MMA(1, 0, At, B0); PG8_MMA(1, 1, At, B1); PG8_BAR; PG8_SCHED;
            PG8_LDB(B0, 1, 0); PG8_LDB(B1, 1, 1); PG8_SCHED; PG8_LDA(At, 1, 0); PG8_STAGE(PG8_SA(0, 1), a2 + hstep, voffA);
            PG8_WAIT_V(8); PG8_WAIT_L(0); PG8_BAR; PG8_MMA(0, 0, At, B0); PG8_MMA(0, 1, At, B1); PG8_BAR; PG8_SCHED;
            PG8_LDA(At, 1, 1); PG8_STAGE(PG8_SB(1, 0), b3, voffB); PG8_STAGE(PG8_SB(1, 1), b3 + hstep, voffB); PG8_STAGE(PG8_SA(1, 0), a3, voffA);
            PG8_WAIT_V(8); PG8_WAIT_L(0); PG8_BAR; PG8_MMA(1, 0, At, B0); PG8_MMA(1, 1, At, B1); PG8_BAR; PG8_SCHED;
            } else {
            PG8_LDB(B0, 0, 0); PG8_SCHED; PG8_LDA(At, 0, 0); PG8_STAGE(PG8_SA(1, 1), a1 + hstep, voffA);
            PG8_WAIT_L(8); PG8_BAR; PG8_WAIT_L(0); PG8_MMA(0, 0, At, B0); PG8_BAR; PG8_SCHED;
            PG8_LDB(B1, 0, 1); PG8_STAGE(PG8_SB(0, 0), b2, voffB);
            PG8_BAR; PG8_WAIT_L(0); PG8_MMA(0, 1, At, B1); PG8_BAR;
            PG8_LDA(At, 0, 1); PG8_STAGE(PG8_SA(0, 0), a2, voffA);
            PG8_BAR; PG8_WAIT_L(0); PG8_MMA(1, 0, At, B0); PG8_BAR; PG8_SCHED;
            PG8_STAGE(PG8_SB(0, 1), b2 + hstep, voffB);
            PG8_WAIT_V(6); PG8_BAR; PG8_MMA(1, 1, At, B1); PG8_BAR;
            PG8_LDB(B0, 1, 0); PG8_SCHED; PG8_LDA(At, 1, 0); PG8_STAGE(PG8_SA(0, 1), a2 + hstep, voffA);
            PG8_WAIT_L(8); PG8_BAR; PG8_WAIT_L(0); PG8_MMA(0, 0, At, B0); PG8_BAR; PG8_SCHED;
            PG8_LDB(B1, 1, 1); PG8_STAGE(PG8_SB(1, 0), b3, voffB);
            PG8_BAR; PG8_WAIT_L(0); PG8_MMA(0, 1, At, B1); PG8_BAR;
            PG8_LDA(At, 1, 1); PG8_STAGE(PG8_SA(1, 0), a3, voffA);
            PG8_BAR; PG8_WAIT_L(0); PG8_MMA(1, 0, At, B0); PG8_BAR; PG8_SCHED;
            PG8_STAGE(PG8_SB(1, 1), b3 + hstep, voffB);
            PG8_WAIT_V(6); PG8_BAR; PG8_MMA(1, 1, At, B1); PG8_BAR;
            }
        }
        if constexpr (ALIGN_EPI) { if (wr == 0) PG8_BAR; }
        E(acc, cur, wr, wc, fr, fq);
        if (!has_next) break;
#pragma unroll
        for (int a = 0; a < 2; ++a)
#pragma unroll
            for (int b = 0; b < 2; ++b)
#pragma unroll
                for (int m = 0; m < 4; ++m)
#pragma unroll
                    for (int n = 0; n < 2; ++n) acc[a][b][m][n] = (f32x4){0.f, 0.f, 0.f, 0.f};
        cur = nxt; cA = nA; cB = nB; ++ui;
        if constexpr (ALIGN_EPI) { if (wr == 1) PG8_BAR; }
    }
    PG8_WAIT_V(0);
    if constexpr (!ALIGN_EPI) { if (wr == 0) PG8_BAR; }
    PG8_BAR;
#undef PG8_SA
#undef PG8_SB
#undef PG8_STAGE
#undef PG8_LDA
#undef PG8_LDB
#undef PG8_MMA
#undef PG8_WAIT_V
#undef PG8_WAIT_L
#undef PG8_BAR
#undef PG8_SCHED
}
}

#define PG8_SP2 true
#define PG8_ALIGN true

constexpr int NWAVES = 8, NTHR = NWAVES * 64;
constexpr int N_LAUNCHES = MK_N_LAUNCHES;
constexpr int PER_PHASE = 12;
constexpr int D = 2048, MP = 8192, MS = 128, MR = MP + MS, MPAD = 8448;
constexpr int NPROJ = 14368, LDP = 14592, DFF = 8192, NMOD = 12288, DCAT = 4096;
constexpr int C_Q = 0, C_F = 2048, C_I = 4096, C_G = 6144, C_Z = 8192, C_X = 10240, C_DT = 14336;
constexpr int KS_IN = 8, KS_OUT = 16, KS_UP = 8, KS_DOWN = 32;
constexpr float EPS = 1e-6f;
constexpr size_t O_YP = 0, O_HP = 17039360, O_SP = 18087936, O_CP = 19136512, O_HS = 19185664, O_SS = 52740096, O_CS = 86294528, O_END = 87867392;

constexpr size_t MiB = 1u << 20;
constexpr size_t WS_CTL = 0, CTL_ZERO_BYTES = 1 * MiB;
constexpr size_t WS_WIN = 1 * MiB;
constexpr size_t WS_WOUT = 58 * MiB;
constexpr size_t WS_WUP = 74 * MiB;
constexpr size_t WS_WDOWN = 106 * MiB;
constexpr size_t WS_MOD = 138 * MiB;
constexpr size_t WS_HN = 145 * MiB;
constexpr size_t WS_PROJ = 178 * MiB;
constexpr size_t WS_RA = 414 * MiB;
constexpr size_t WS_SLABDT = WS_RA + 57 * MiB, WS_DTB = WS_RA + 65 * MiB;
constexpr size_t WS_RB = 481 * MiB;
constexpr size_t WS_RC = 546 * MiB;
constexpr size_t WS_END = 611 * MiB;
constexpr int CW_BAR = 4096;

constexpr int RING_BYTES = 131072, LDSCTL_OFF = RING_BYTES, MISC_OFF = LDSCTL_OFF + 320, LDS_BYTES = 147456;

#define GAS __attribute__((address_space(1)))
#define LAS __attribute__((address_space(3)))
typedef unsigned short bf16;
typedef unsigned v4u __attribute__((ext_vector_type(4)));
typedef unsigned v2u __attribute__((ext_vector_type(2)));
typedef float f32x4 __attribute__((ext_vector_type(4)));
typedef float f32x2 __attribute__((ext_vector_type(2)));
typedef short bf16x8 __attribute__((ext_vector_type(8)));
typedef GAS unsigned gu32;
#define RLX_AGENT __ATOMIC_RELAXED, __HIP_MEMORY_SCOPE_AGENT
#define LDS_WAIT() asm volatile("s_waitcnt lgkmcnt(0)" ::: "memory")
#define VM_WAIT() asm volatile("s_waitcnt vmcnt(0)" ::: "memory")
__device__ __forceinline__ unsigned f2bf(float f) { unsigned u = __builtin_bit_cast(unsigned, f); return (u + 0x7fffu + ((u >> 16) & 1u)) >> 16; }
__device__ __forceinline__ unsigned pk2(float lo, float hi) { return f2bf(lo) | (f2bf(hi) << 16); }
__device__ __forceinline__ float bflo(unsigned w) { return __builtin_bit_cast(float, w << 16); }
__device__ __forceinline__ float bfhi(unsigned w) { return __builtin_bit_cast(float, w & 0xffff0000u); }
__device__ __forceinline__ float bf1(bf16 h) { return __builtin_bit_cast(float, (unsigned)h << 16); }
__device__ __forceinline__ float sigmoidf_(float x) { return __builtin_amdgcn_rcpf(1.f + __expf(-x)); }
__device__ __forceinline__ float siluf_(float x) { return x * sigmoidf_(x); }
__device__ __forceinline__ float softplusf_(float x) { return fmaxf(x, 0.f) + log1pf(__expf(-fabsf(x))); }
__device__ __forceinline__ float wave_sum(float v) {
#pragma unroll
    for (int o = 1; o < 64; o <<= 1) v += __shfl_xor(v, o);
    return v;
}

#define XB_TMO      128
#define XB_XCNT(j)  (256  + 64 * (j))
#define XB_XSUB(j)  (1280 + 64 * (j))
#define XB_XGEN(j)  (2304 + 64 * (j))
#define XB_TOP      3328
#define XB_TOPGEN   3392
#define XCD_BAR_WORDS 3456
#define XB_SPIN_CAP (1u << 22)

__device__ __forceinline__ unsigned xb_ld(unsigned* p)              { return __hip_atomic_load(p, __ATOMIC_RELAXED, __HIP_MEMORY_SCOPE_AGENT); }
__device__ __forceinline__ unsigned xb_add(unsigned* p, unsigned v) { return __hip_atomic_fetch_add(p, v, __ATOMIC_RELAXED, __HIP_MEMORY_SCOPE_AGENT); }
__device__ __forceinline__ unsigned xb_xcc_id() { return (unsigned)__builtin_amdgcn_s_getreg((3 << 11) | 20) & 0xFu; }
#define XB_SPIN(cond, bar) do { unsigned _sp = 0; while (cond) { __builtin_amdgcn_s_sleep(1); \
    if ((++_sp & 255u) == 0u) { if (xb_ld(&(bar)[XB_TMO])) break; if (_sp > XB_SPIN_CAP) { atomicAdd(&(bar)[XB_TMO], 1u); break; } } } } while (0)

struct XcdBarrier { unsigned* bar; unsigned x; volatile LAS unsigned* st; };

__device__ __forceinline__ XcdBarrier xcd_barrier_post(unsigned* bar, volatile LAS unsigned* st) {
    XcdBarrier b; b.bar = bar; b.x = xb_xcc_id(); b.st = st;
    if (threadIdx.x == 0) (void)xb_add(&bar[XB_XCNT(b.x)], 1u);
    return b;
}
__device__ __forceinline__ void xcd_barrier_complete(unsigned* bar, unsigned x, unsigned& nloc, unsigned& nx) {
    const unsigned G = gridDim.x * gridDim.y * gridDim.z;
    unsigned sum, cnt, mine, sp = 0u;
    for (;;) {
        sum = 0u; cnt = 0u; mine = 0u;
#pragma unroll
        for (unsigned j = 0; j < 16; ++j) { const unsigned c = xb_ld(&bar[XB_XCNT(j)]); sum += c; cnt += (c > 0u) ? 1u : 0u; mine = (j == x) ? c : mine; }
        if (sum == G) break;
        __builtin_amdgcn_s_sleep(1);
        if ((++sp & 255u) == 0u) { if (xb_ld(&bar[XB_TMO])) break; if (sp > XB_SPIN_CAP) { atomicAdd(&bar[XB_TMO], 1u); break; } }
    }
    nloc = mine > 0u ? mine : 1u; nx = cnt > 0u ? cnt : 1u;
}
__device__ __forceinline__ void xcd_barrier(const XcdBarrier& b) {
    asm volatile("s_waitcnt vmcnt(0)" ::: "memory");
    __syncthreads();
    if (threadIdx.x == 0) {
        unsigned* bar = b.bar;
        __builtin_amdgcn_s_waitcnt(0);
        unsigned nloc = b.st[0], nx = b.st[1];
        if (nloc == 0u) { xcd_barrier_complete(bar, b.x, nloc, nx); b.st[0] = nloc; b.st[1] = nx; }
        const unsigned old = xb_add(&bar[XB_XSUB(b.x)], 1u);
        const unsigned gen = old / nloc;
        if (old + 1u == (gen + 1u) * nloc) {
            __builtin_amdgcn_fence(__ATOMIC_RELEASE, "agent");
            asm volatile("s_waitcnt vmcnt(0)" ::: "memory");
            const unsigned og = xb_add(&bar[XB_TOP], 1u);
            const unsigned tg = og / nx;
            if (og + 1u == (tg + 1u) * nx) xb_add(&bar[XB_TOPGEN], 1u);
            else XB_SPIN(xb_ld(&bar[XB_TOPGEN]) == tg, bar);
            __builtin_amdgcn_fence(__ATOMIC_ACQUIRE, "agent");
            xb_add(&bar[XB_XGEN(b.x)], 1u);
            asm volatile("s_waitcnt vmcnt(0)" ::: "memory");
        } else {
            XB_SPIN(xb_ld(&bar[XB_XGEN(b.x)]) == gen, bar);
            __builtin_amdgcn_fence(__ATOMIC_ACQUIRE, "agent");
            asm volatile("s_waitcnt vmcnt(0)" ::: "memory");
        }
    }
    __syncthreads();
}

struct Args { const float* in[25]; float* out; unsigned char* ws; int ph_lo, ph_hi; };
enum { I_XP = 0, I_XS, I_CP, I_CS, I_SH, I_SS, I_SC, I_WADA, I_BADA, I_GPREMIX, I_GPOSTMIX, I_GPREMLP, I_GPOSTMLP, I_WIN, I_LB, I_HNORM, I_CONVW, I_CONVB, I_DTB, I_ALOG, I_DSKIP, I_SNORM, I_WOUT, I_WUP, I_WDOWN };

__device__ __forceinline__ void p0_transpose_item(const float* W, int K, int N, bf16* WT, LAS float* scr, int item, int lane) {
    const int nblk = N / 32, kb = item / nblk, nb = item % nblk, k0 = 64 * kb, n0 = 32 * nb;
#pragma unroll 8
    for (int i = 0; i < 32; ++i) { const int kk = 2 * i + (lane >> 5); scr[kk * 33 + (lane & 31)] = W[(size_t)(k0 + kk) * N + n0 + (lane & 31)]; }
    LDS_WAIT(); asm volatile("" ::: "memory");
    const int c = lane & 7;
#pragma unroll
    for (int j = 0; j < 4; ++j) { const int n = (lane >> 3) + 8 * j; const LAS float* s = scr + (8 * c) * 33 + n;
        v4u o; o.x = pk2(s[0 * 33], s[1 * 33]); o.y = pk2(s[2 * 33], s[3 * 33]); o.z = pk2(s[4 * 33], s[5 * 33]); o.w = pk2(s[6 * 33], s[7 * 33]);
        *(GAS v4u*)(WT + (size_t)(n0 + n) * K + k0 + 8 * c) = o; }
    LDS_WAIT(); asm volatile("" ::: "memory");
}

__device__ __forceinline__ void p0_adaln_job(const float* cp, const float* cs, const float* wada, const float* bada, float* mod, LAS float* red, int job, int wave, int lane, int tid) {
    const int n0 = job * 48;
    f32x4 acc[9][3];
#pragma unroll
    for (int a = 0; a < 9; ++a)
#pragma unroll
        for (int b = 0; b < 3; ++b) acc[a][b] = (f32x4){0.f, 0.f, 0.f, 0.f};
    const int kq = 8 * (lane >> 4), lr = lane & 15;
#pragma unroll 1
    for (int ks = 0; ks < 8; ++ks) {
        const int kk = wave * 256 + ks * 32 + kq;
        bf16x8 bfr[3];
#pragma unroll
        for (int nt = 0; nt < 3; ++nt) {
            const float* wp = wada + (size_t)kk * NMOD + n0 + nt * 16 + lr;
            float w[8];
#pragma unroll
            for (int j = 0; j < 8; ++j) w[j] = wp[(size_t)j * NMOD];
            v4u p; p.x = pk2(w[0], w[1]); p.y = pk2(w[2], w[3]); p.z = pk2(w[4], w[5]); p.w = pk2(w[6], w[7]);
            bfr[nt] = __builtin_bit_cast(bf16x8, p);
        }
#pragma unroll
        for (int mt = 0; mt < 9; ++mt) {
            const int m = mt * 16 + lr;
            f32x4 c0 = (f32x4){0.f, 0.f, 0.f, 0.f}, c1 = c0;
            if (m < 132) { const float* src = (m < 4) ? (cp + (size_t)m * D) : (cs + (size_t)(m - 4) * D); c0 = *(const f32x4*)(src + kk); c1 = *(const f32x4*)(src + kk + 4); }
            v4u p; p.x = pk2(siluf_(c0[0]), siluf_(c0[1])); p.y = pk2(siluf_(c0[2]), siluf_(c0[3])); p.z = pk2(siluf_(c1[0]), siluf_(c1[1])); p.w = pk2(siluf_(c1[2]), siluf_(c1[3]));
            const bf16x8 afr = __builtin_bit_cast(bf16x8, p);
#pragma unroll
            for (int nt = 0; nt < 3; ++nt) acc[mt][nt] = __builtin_amdgcn_mfma_f32_16x16x32_bf16(afr, bfr[nt], acc[mt][nt], 0, 0, 0);
        }
    }
    for (int r = 0; r < 8; ++r) {
        if (wave == r) {
#pragma unroll
            for (int mt = 0; mt < 9; ++mt)
#pragma unroll
                for (int nt = 0; nt < 3; ++nt)
#pragma unroll
                    for (int i = 0; i < 4; ++i) { const int idx = (mt * 16 + (lane >> 4) * 4 + i) * 48 + nt * 16 + lr; const float prev = (r == 0) ? 0.f : red[idx]; red[idx] = prev + acc[mt][nt][i]; }
        }
        __syncthreads();
    }
    for (int idx = tid; idx < 132 * 48; idx += NTHR) { const int m = idx / 48, c = idx - m * 48; mod[(size_t)m * NMOD + n0 + c] = red[idx] + bada[n0 + c]; }
    __syncthreads();
}

__global__ void __launch_bounds__(NTHR, 2) hymba_fwd(Args args) {
    extern __shared__ __attribute__((aligned(16))) unsigned char lds_raw[];
    LAS unsigned char* lds = (LAS unsigned char*)lds_raw;
    LAS float* Lf = (LAS float*)lds;
    volatile LAS unsigned* MISC = (volatile LAS unsigned*)(lds + MISC_OFF);
    const int G = gridDim.x, bid = blockIdx.x;
#define PHASE_IDS() int tid_o = threadIdx.x; asm volatile("" : "+v"(tid_o)); const int tid = tid_o, lane = tid & 63, wave = __builtin_amdgcn_readfirstlane(tid >> 6), gw = bid * NWAVES + wave, NGW = G * NWAVES; (void)lane; (void)gw; (void)NGW
    typedef const __attribute__((address_space(4))) Args* kargs_t;
#define PHASE_ARGS() kargs_t ap = (kargs_t)__builtin_amdgcn_kernarg_segment_ptr(); asm volatile("" : "+s"(ap)); unsigned char* ws = ap->ws; float* out = ap->out; (void)out; \
    bf16* WIN_T = (bf16*)(ws + WS_WIN); bf16* WOUT_T = (bf16*)(ws + WS_WOUT); bf16* WUP_T = (bf16*)(ws + WS_WUP); bf16* WDOWN_T = (bf16*)(ws + WS_WDOWN); \
    float* MOD = (float*)(ws + WS_MOD); bf16* HN = (bf16*)(ws + WS_HN); bf16* PROJ = (bf16*)(ws + WS_PROJ); bf16* UB = (bf16*)(ws + WS_PROJ); \
    float* SLAB_IN = (float*)(ws + WS_RA); float* SLAB_DT = (float*)(ws + WS_SLABDT); float* DTB = (float*)(ws + WS_DTB); \
    bf16* CAT = (bf16*)(ws + WS_RA); float* SLAB_UP = (float*)(ws + WS_RA); \
    float* OA_RAW = (float*)(ws + WS_RB); float* MIX = (float*)(ws + WS_RB); float* MLP = (float*)(ws + WS_RB); \
    float* Y_RAW = (float*)(ws + WS_RC); float* SLAB_OUT = (float*)(ws + WS_RC); float* SLAB_DOWN = (float*)(ws + WS_RC); \
    (void)WIN_T; (void)WOUT_T; (void)WUP_T; (void)WDOWN_T; (void)MOD; (void)HN; (void)PROJ; (void)UB; (void)SLAB_IN; (void)SLAB_DT; (void)DTB; (void)CAT; (void)SLAB_UP; (void)OA_RAW; (void)MIX; (void)MLP; (void)Y_RAW; (void)SLAB_OUT; (void)SLAB_DOWN
#define AIN(i) ((const float*)ap->in[i])
    kargs_t ap0 = (kargs_t)__builtin_amdgcn_kernarg_segment_ptr();
    gu32* ctl = (gu32*)(ap0->ws + WS_CTL);

    for (int u = threadIdx.x; u < (LDS_BYTES - LDSCTL_OFF) / 4; u += NTHR) ((LAS unsigned*)(lds + LDSCTL_OFF))[u] = 0u;
    __syncthreads();
    XcdBarrier bar; bar.bar = (unsigned*)(ctl + CW_BAR); bar.x = 0; bar.st = nullptr;
    if (N_LAUNCHES != PER_PHASE) bar = xcd_barrier_post((unsigned*)(ctl + CW_BAR), MISC + 8);
    const int lo = ap0->ph_lo, hi = ap0->ph_hi;
#define IN(k) (lo <= (k) && (k) < hi)
#define SEAM(k) do { if (IN(k) && IN((k) + 1)) xcd_barrier(bar); } while (0)

    if (IN(0)) {
        PHASE_ARGS();
        PHASE_IDS();
        for (int job = bid; job < 256; job += G)
            p0_adaln_job(AIN(I_CP), AIN(I_CS), AIN(I_WADA), AIN(I_BADA), MOD, Lf, job, wave, lane, tid);
        LAS float* scr = Lf + wave * 4096;
        constexpr int IT_IN = (D / 64) * (NPROJ / 32), IT_OUT = (DCAT / 64) * (D / 32), IT_UP = (D / 64) * (DFF / 32), IT_DOWN = (DFF / 64) * (D / 32);
        constexpr int NITEMS = IT_IN + IT_OUT + IT_UP + IT_DOWN;
        for (int it = gw; it < NITEMS; it += NGW) {
            int r = it;
            if (r < IT_IN) { p0_transpose_item(AIN(I_WIN), D, NPROJ, WIN_T, scr, r, lane); continue; } r -= IT_IN;
            if (r < IT_OUT) { p0_transpose_item(AIN(I_WOUT), DCAT, D, WOUT_T, scr, r, lane); continue; } r -= IT_OUT;
            if (r < IT_UP) { p0_transpose_item(AIN(I_WUP), D, DFF, WUP_T, scr, r, lane); continue; } r -= IT_UP;
            p0_transpose_item(AIN(I_WDOWN), DFF, D, WDOWN_T, scr, r, lane);
        }
        { v4u z = (v4u){0u, 0u, 0u, 0u}; GAS v4u* p = (GAS v4u*)(WIN_T + (size_t)NPROJ * D); const int n16 = (LDP - NPROJ) * D * 2 / 16;
          for (int i = bid * NTHR + tid; i < n16; i += G * NTHR) p[i] = z; }
    }
    SEAM(0);

    if (IN(1)) {
        PHASE_ARGS();
        PHASE_IDS();
        const float* gpre = AIN(I_GPREMIX);
        for (int r = gw; r < MPAD; r += NGW) {
            GAS v2u* o8 = (GAS v2u*)(HN + (size_t)r * D) + lane;
            if (r >= MR) {
#pragma unroll
                for (int j = 0; j < 8; ++j) o8[64 * j] = (v2u){0u, 0u};
                continue; }
            const float* xr = (r < MP) ? AIN(I_XP) + (size_t)r * D : AIN(I_XS) + (size_t)(r - MP) * D;
            const float* mrow = MOD + (size_t)((r < MP) ? (r >> 11) : (4 + r - MP)) * NMOD;
            f32x4 v[8]; float ss = 0.f;
#pragma unroll
            for (int j = 0; j < 8; ++j) { v[j] = *((const f32x4*)xr + lane + 64 * j); ss += (v[j][0] * v[j][0] + v[j][1] * v[j][1]) + (v[j][2] * v[j][2] + v[j][3] * v[j][3]); }
            const float rinv = rsqrtf(wave_sum(ss) * (1.f / D) + EPS);
#pragma unroll
            for (int j = 0; j < 8; ++j) { const int c = 4 * lane + 256 * j;
                const f32x4 g = *(const f32x4*)(gpre + c), sh = *(const f32x4*)(mrow + c), sc = *(const f32x4*)(mrow + D + c);
                const f32x4 h = v[j] * rinv * g * (sc + 1.f) + sh;
                o8[64 * j] = (v2u){pk2(h[0], h[1]), pk2(h[2], h[3])}; }
        }
    }
    SEAM(1);

    if (IN(2)) {
        PHASE_ARGS();
        { pg8::Gemm g{HN, WIN_T, D, D / 64}; pg8::FullOrder S; S.init(MP / 256, 56, G, bid);
          pg8::EpiBf16<0> E{PROJ, LDP};
          pg8::gemm_phase<pg8::EpiBf16<0>, pg8::FullOrder, PG8_ALIGN, PG8_SP2>(lds, g, S, E); }
        { pg8::Gemm g{HN, WIN_T, D, D / 64 / KS_IN}; pg8::SplitOrder S{32 * KS_IN, 56, 57 * KS_IN, 32, 3, G, bid};
          pg8::EpiSlab E{SLAB_IN, LDP, 32, SLAB_DT, MP};
          pg8::gemm_phase<pg8::EpiSlab, pg8::SplitOrder, PG8_ALIGN, PG8_SP2>(lds, g, S, E); }
    }
    SEAM(2);

    if (IN(3)) {
        PHASE_ARGS();
        PHASE_IDS();
        const int n4 = MS * LDP / 4;
        for (int i = bid * NTHR + tid; i < n4; i += G * NTHR) {
            const int e = 4 * i, r = e / LDP, c = e - r * LDP;
            f32x4 s = (f32x4){0.f, 0.f, 0.f, 0.f};
#pragma unroll
            for (int k = 0; k < KS_IN; ++k) s += *(const f32x4*)(SLAB_IN + ((size_t)k * 128 + r) * LDP + c);
            *(GAS v2u*)(PROJ + (size_t)(MP + r) * LDP + c) = (v2u){pk2(s[0], s[1]), pk2(s[2], s[3])};
        }
        const float* dtb = AIN(I_DTB);
        for (int i = bid * NTHR + tid; i < MR * 32; i += G * NTHR) {
            const int row = i >> 5, h = i & 31; float s = 0.f;
            if (row < MP) {
#pragma unroll
                for (int k = 0; k < KS_IN; ++k) s += SLAB_DT[((size_t)k * MP + row) * 32 + h];
            } else {
#pragma unroll
                for (int k = 0; k < KS_IN; ++k) s += SLAB_IN[((size_t)k * 128 + (row - MP)) * LDP + C_DT + h];
            }
            DTB[i] = softplusf_(s + dtb[h]);
        }
    }
    SEAM(3);

    if (IN(4)) {
        PHASE_ARGS();
        PHASE_IDS();
        const float* lbl = AIN(I_LB);
        const float* convw = AIN(I_CONVW); const float* convb = AIN(I_CONVB);
        const int NU = 256 + 256 + 2048 + 1024 + 12 + 384;
        for (int u = bid; u < NU; u += G) {
            if (u < 256) {
                const int b = u >> 6, h = (u >> 2) & 15, vsl = u & 3;
                LAS float* qs = Lf; LAS float* fs = Lf + 4096; LAS float* vsm = Lf + 8192; LAS float* part = Lf + 9216;
                const int v = tid & 31, kg = tid >> 5;
                const int stt = tid >> 4, k8 = (tid & 15) * 8;
                float lb8[8];
#pragma unroll
                for (int j = 0; j < 8; ++j) { const int c = h * 128 + k8 + j; lb8[j] = sigmoidf_(lbl[c] - lbl[D + c]); }
                float S[8];
#pragma unroll
                for (int j = 0; j < 8; ++j) S[j] = 0.f;
                for (int c0 = 0; c0 < 2048; c0 += 32) {
                    const size_t row0 = (size_t)b * 2048 + c0;
                    { const bf16* pr = PROJ + (row0 + stt) * LDP + h * 128 + k8;
                      const v4u q = *(const GAS v4u*)(pr + C_Q), f = *(const GAS v4u*)(pr + C_F);
                      const unsigned qa[4] = {q.x, q.y, q.z, q.w}, fa[4] = {f.x, f.y, f.z, f.w};
#pragma unroll
                      for (int j = 0; j < 4; ++j) {
                          qs[stt * 128 + k8 + 2 * j] = siluf_(bflo(qa[j])); qs[stt * 128 + k8 + 2 * j + 1] = siluf_(bfhi(qa[j]));
                          fs[stt * 128 + k8 + 2 * j] = lb8[2 * j] + (1.f - lb8[2 * j]) * sigmoidf_(bflo(fa[j]));
                          fs[stt * 128 + k8 + 2 * j + 1] = lb8[2 * j + 1] + (1.f - lb8[2 * j + 1]) * sigmoidf_(bfhi(fa[j])); }
                      if (tid < 128) { const int tt = tid >> 2, sg = (tid & 3) * 8;
                          const v4u iv = *(const GAS v4u*)(PROJ + (row0 + tt) * LDP + C_I + h * 128 + vsl * 32 + sg);
                          const unsigned ia[4] = {iv.x, iv.y, iv.z, iv.w};
#pragma unroll
                          for (int j = 0; j < 4; ++j) { vsm[tt * 32 + sg + 2 * j] = bflo(ia[j]); vsm[tt * 32 + sg + 2 * j + 1] = bfhi(ia[j]); } }
                    }
                    __syncthreads();
#pragma unroll 4
                    for (int t = 0; t < 32; ++t) {
                        const f32x4 f0 = *(const LAS f32x4*)(fs + t * 128 + kg * 8), f1 = *(const LAS f32x4*)(fs + t * 128 + kg * 8 + 4);
                        const f32x4 q0 = *(const LAS f32x4*)(qs + t * 128 + kg * 8), q1 = *(const LAS f32x4*)(qs + t * 128 + kg * 8 + 4);
                        const float vv = vsm[t * 32 + v];
                        float p = 0.f;
#pragma unroll
                        for (int j = 0; j < 4; ++j) { S[j] = f0[j] * S[j] + (1.f - f0[j]) * vv; p += q0[j] * S[j]; }
#pragma unroll
                        for (int j = 0; j < 4; ++j) { S[4 + j] = f1[j] * S[4 + j] + (1.f - f1[j]) * vv; p += q1[j] * S[4 + j]; }
                        p += __shfl_xor(p, 32);
                        if (lane < 32) part[(t * 8 + wave) * 32 + v] = p;
                    }
                    __syncthreads();
                    { const int t = tid >> 4, v2 = (tid & 15) * 2; float o0 = 0.f, o1 = 0.f;
#pragma unroll
                      for (int w = 0; w < 8; ++w) { const f32x2 pp = *(const LAS f32x2*)(part + (t * 8 + w) * 32 + v2); o0 += pp[0]; o1 += pp[1]; }
                      *(f32x2*)(OA_RAW + (row0 + t) * D + h * 128 + vsl * 32 + v2) = (f32x2){o0, o1}; }
                }
#pragma unroll
                for (int j = 0; j < 8; ++j) out[O_HP + ((size_t)(b * 16 + h) * 128 + kg * 8 + j) * 128 + vsl * 32 + v] = S[j];
                __syncthreads();
            } else if (u < 512) {
                const int uu = u - 256, b = uu >> 6, h = (uu >> 1) & 31, ph = uu & 1, g = h >> 2;
                LAS float* xs = Lf; LAS float* Bs = Lf + 1024; LAS float* Cs = Lf + 5120; LAS float* dts = Lf + 9216; LAS float* das = Lf + 9248; LAS float* ys = Lf + 9280;
                int col = 0; LAS float* dst = xs; int dstride = 32, didx = 0;
                if (tid < 32) { col = h * 64 + ph * 32 + tid; dst = xs; dstride = 32; didx = tid; }
                else if (tid < 160) { col = 2048 + g * 128 + (tid - 32); dst = Bs; dstride = 128; didx = tid - 32; }
                else if (tid < 288) { col = 3072 + g * 128 + (tid - 160); dst = Cs; dstride = 128; didx = tid - 160; }
                const bool isconv = tid < 288;
                float w0 = 0.f, w1 = 0.f, w2 = 0.f, w3 = 0.f, cb = 0.f, r0 = 0.f, r1 = 0.f, r2 = 0.f;
                if (isconv) { w0 = convw[col]; w1 = convw[4096 + col]; w2 = convw[8192 + col]; w3 = convw[12288 + col]; cb = convb[col]; }
                const float a_h = -__expf(AIN(I_ALOG)[h]), dsk = AIN(I_DSKIP)[h];
                const int p = tid >> 4, nq = tid & 15;
                float hs[8];
#pragma unroll
                for (int j = 0; j < 8; ++j) hs[j] = 0.f;
                for (int c0 = 0; c0 < 2048; c0 += 32) {
                    const size_t row0 = (size_t)b * 2048 + c0;
                    if (isconv) {
                        const bf16* pr = PROJ + row0 * LDP + C_X + col;
                        float raw[32];
#pragma unroll
                        for (int tt = 0; tt < 32; ++tt) raw[tt] = bf1(pr[(size_t)tt * LDP]);
#pragma unroll
                        for (int tt = 0; tt < 32; ++tt) { const float val = cb + w0 * r0 + w1 * r1 + w2 * r2 + w3 * raw[tt]; dst[tt * dstride + didx] = siluf_(val); r0 = r1; r1 = r2; r2 = raw[tt]; }
                    } else if (tid < 320) { const int tt = tid - 288; const float dt = DTB[(row0 + tt) * 32 + h]; dts[tt] = dt; das[tt] = __expf(dt * a_h); }
                    __syncthreads();
#pragma unroll 4
                    for (int t = 0; t < 32; ++t) {
                        const f32x4 B0 = *(const LAS f32x4*)(Bs + t * 128 + nq * 8), B1 = *(const LAS f32x4*)(Bs + t * 128 + nq * 8 + 4);
                        const f32x4 C0 = *(const LAS f32x4*)(Cs + t * 128 + nq * 8), C1 = *(const LAS f32x4*)(Cs + t * 128 + nq * 8 + 4);
                        const float x = xs[t * 32 + p], dt = dts[t], dA = das[t], xdt = x * dt;
                        float y = 0.f;
#pragma unroll
                        for (int j = 0; j < 4; ++j) { hs[j] = dA * hs[j] + xdt * B0[j]; y += hs[j] * C0[j]; }
#pragma unroll
                        for (int j = 0; j < 4; ++j) { hs[4 + j] = dA * hs[4 + j] + xdt * B1[j]; y += hs[4 + j] * C1[j]; }
                        y += __shfl_xor(y, 1); y += __shfl_xor(y, 2); y += __shfl_xor(y, 4); y += __shfl_xor(y, 8);
                        if (nq == 0) ys[t * 32 + p] = y + dsk * x;
                    }
                    __syncthreads();
                    { const int t = tid >> 4, p2 = (tid & 15) * 2;
                      *(f32x2*)(Y_RAW + (row0 + t) * D + h * 64 + ph * 32 + p2) = *(const LAS f32x2*)(ys + t * 32 + p2); }
                }
#pragma unroll
                for (int j = 0; j < 8; ++j) out[O_SP + ((size_t)(b * 32 + h) * 64 + ph * 32 + p) * 128 + nq * 8 + j] = hs[j];
                __syncthreads();
            } else if (u < 512 + 2048) {
                const int uu = u - 512, s = uu >> 4, h = uu & 15;
                LAS float* qv = Lf; LAS float* fv = Lf + 128; LAS float* kv = Lf + 256; LAS float* iv = Lf + 384; LAS float* red = Lf + 512;
                if (tid < 128) { const int c = h * 128 + tid; const bf16* pr = PROJ + (size_t)(MP + s) * LDP + c;
                    const float lb = sigmoidf_(lbl[c] - lbl[D + c]);
                    const float sg = sigmoidf_(bf1(pr[C_F]));
                    qv[tid] = siluf_(bf1(pr[C_Q])); fv[tid] = lb + (1.f - lb) * sg; kv[tid] = (1.f - lb) * (1.f - sg); iv[tid] = bf1(pr[C_I]); }
                __syncthreads();
                const int v4 = (tid & 31) * 4, kr = tid >> 5;
                const f32x4 i4 = *(const LAS f32x4*)(iv + v4);
                f32x4 o4 = (f32x4){0.f, 0.f, 0.f, 0.f};
                const size_t sb = ((size_t)(s * 16 + h) * 128) * 128 + v4;
                const float* S0 = AIN(I_SH) + sb; float* S1 = out + O_HS + sb;
                f32x4 sv[8];
#pragma unroll
                for (int i = 0; i < 8; ++i) sv[i] = *(const f32x4*)(S0 + (size_t)(kr + 16 * i) * 128);
#pragma unroll
                for (int i = 0; i < 8; ++i) { const int k = kr + 16 * i; const f32x4 nv = sv[i] * fv[k] + i4 * kv[k]; *(f32x4*)(S1 + (size_t)k * 128) = nv; o4 += nv * qv[k]; }
                *(LAS f32x4*)(red + kr * 128 + v4) = o4;
                __syncthreads();
                if (tid < 128) { float o = 0.f;
#pragma unroll
                    for (int r = 0; r < 16; ++r) o += red[r * 128 + tid];
                    OA_RAW[(size_t)(MP + s) * D + h * 128 + tid] = o; }
                __syncthreads();
            } else if (u < 512 + 2048 + 1024) {
                const int uu = u - 2560, s = uu >> 3, g = uu & 7;
                LAS float* xc = Lf; LAS float* Bc = Lf + 256; LAS float* Cc = Lf + 384; LAS float* dtv = Lf + 512; LAS float* dav = Lf + 516;
                { int col; LAS float* dst;
                  if (tid < 256) { col = g * 256 + tid; dst = xc + tid; } else if (tid < 384) { col = 2048 + g * 128 + (tid - 256); dst = Bc + (tid - 256); } else { col = 3072 + g * 128 + (tid - 384); dst = Cc + (tid - 384); }
                  const float* sc = AIN(I_SC) + (size_t)s * 3 * 4096 + col;
                  const float raw = bf1(PROJ[(size_t)(MP + s) * LDP + C_X + col]);
                  const float val = convb[col] + convw[col] * sc[0] + convw[4096 + col] * sc[4096] + convw[8192 + col] * sc[8192] + convw[12288 + col] * raw;
                  *dst = siluf_(val);
                  if (tid < 4) { const int h = 4 * g + tid; const float dt = DTB[(size_t)(MP + s) * 32 + h]; dtv[tid] = dt; dav[tid] = __expf(dt * -__expf(AIN(I_ALOG)[h])); } }
                __syncthreads();
                const int n4 = (tid & 31) * 4, pr_ = tid >> 5;
                const f32x4 B4 = *(const LAS f32x4*)(Bc + n4), C4 = *(const LAS f32x4*)(Cc + n4);
#pragma unroll
                for (int hh = 0; hh < 4; ++hh) {
                    const int h = 4 * g + hh; const float dt = dtv[hh], dA = dav[hh], dsk = AIN(I_DSKIP)[h];
                    const size_t sb = ((size_t)(s * 32 + h) * 64) * 128 + n4;
                    const float* H0 = AIN(I_SS) + sb; float* H1 = out + O_SS + sb;
                    f32x4 hv[4];
#pragma unroll
                    for (int i = 0; i < 4; ++i) hv[i] = *(const f32x4*)(H0 + (size_t)(pr_ + 16 * i) * 128);
#pragma unroll
                    for (int i = 0; i < 4; ++i) { const int p = pr_ + 16 * i; const float x = xc[hh * 64 + p]; const f32x4 nv = hv[i] * dA + B4 * (dt * x); *(f32x4*)(H1 + (size_t)p * 128) = nv;
                        const f32x4 yc = nv * C4; float y = (yc[0] + yc[1]) + (yc[2] + yc[3]);
                        y += __shfl_xor(y, 1); y += __shfl_xor(y, 2); y += __shfl_xor(y, 4); y += __shfl_xor(y, 8); y += __shfl_xor(y, 16);
                        if ((tid & 31) == 0) Y_RAW[(size_t)(MP + s) * D + h * 64 + p] = y + dsk * x; }
                }
                __syncthreads();
            } else if (u < 512 + 2048 + 1024 + 12) {
                const int uu = u - 3584, b = uu / 3, j = uu - 3 * b;
                for (int c = tid; c < 4096; c += NTHR) out[O_CP + (size_t)(b * 3 + j) * 4096 + c] = bf1(PROJ[((size_t)b * 2048 + 2045 + j) * LDP + C_X + c]);
            } else {
                const int uu = u - 3596, s = uu / 3, j = uu - 3 * s;
                for (int c = tid; c < 4096; c += NTHR) out[O_CS + (size_t)(s * 3 + j) * 4096 + c] = (j < 2) ? AIN(I_SC)[(size_t)(s * 3 + j + 1) * 4096 + c] : bf1(PROJ[(size_t)(MP + s) * LDP + C_X + c]);
            }
        }
    }
    SEAM(4);

    if (IN(5)) {
        PHASE_ARGS();
        PHASE_IDS();
        const float* hnorm = AIN(I_HNORM); const float* snorm = AIN(I_SNORM);
        for (int r = gw; r < MPAD; r += NGW) {
            bf16* crow = CAT + (size_t)r * DCAT;
            if (r >= MR) {
#pragma unroll
                for (int j = 0; j < 8; ++j) *((GAS v4u*)crow + lane + 64 * j) = (v4u){0u, 0u, 0u, 0u};
                continue; }
            const bf16* prow = PROJ + (size_t)r * LDP;
#pragma unroll
            for (int j = 0; j < 8; ++j) { const int c = 4 * lane + 256 * j;
                const f32x4 o = *(const f32x4*)(OA_RAW + (size_t)r * D + c);
                float ss = (o[0] * o[0] + o[1] * o[1]) + (o[2] * o[2] + o[3] * o[3]);
                ss += __shfl_xor(ss, 1); ss += __shfl_xor(ss, 2); ss += __shfl_xor(ss, 4); ss += __shfl_xor(ss, 8); ss += __shfl_xor(ss, 16);
                const float rinv = rsqrtf(ss * (1.f / 128.f) + EPS);
                const v2u gg = *(const GAS v2u*)(prow + C_G + c); const f32x4 hn = *(const f32x4*)(hnorm + c);
                const float g0 = siluf_(bflo(gg.x)), g1 = siluf_(bfhi(gg.x)), g2 = siluf_(bflo(gg.y)), g3 = siluf_(bfhi(gg.y));
                *(GAS v2u*)(crow + c) = (v2u){pk2(o[0] * rinv * hn[0] * g0, o[1] * rinv * hn[1] * g1), pk2(o[2] * rinv * hn[2] * g2, o[3] * rinv * hn[3] * g3)}; }
#pragma unroll
            for (int j = 0; j < 8; ++j) { const int c = 4 * lane + 256 * j;
                const f32x4 y = *(const f32x4*)(Y_RAW + (size_t)r * D + c);
                const v2u zz = *(const GAS v2u*)(prow + C_Z + c); const f32x4 sn = *(const f32x4*)(snorm + c);
                const float a0 = y[0] * siluf_(bflo(zz.x)), a1 = y[1] * siluf_(bfhi(zz.x)), a2 = y[2] * siluf_(bflo(zz.y)), a3 = y[3] * siluf_(bfhi(zz.y));
                const float ss = wave_sum((a0 * a0 + a1 * a1) + (a2 * a2 + a3 * a3));
                const float rinv = rsqrtf(ss * (1.f / 256.f) + EPS);
                *(GAS v2u*)(crow + D + c) = (v2u){pk2(a0 * rinv * sn[0], a1 * rinv * sn[1]), pk2(a2 * rinv * sn[2], a3 * rinv * sn[3])}; }
        }
    }
    SEAM(5);

    if (IN(6)) {
        PHASE_ARGS();
        { pg8::Gemm g{CAT, WOUT_T, DCAT, DCAT / 64}; pg8::FullOrder S; S.init(MP / 256, D / 256, G, bid);
          pg8::EpiF32 E{MIX, D};
          pg8::gemm_phase<pg8::EpiF32, pg8::FullOrder, PG8_ALIGN, PG8_SP2>(lds, g, S, E); }
        { pg8::Gemm g{CAT, WOUT_T, DCAT, DCAT / 64 / KS_OUT}; pg8::SplitOrder S{0, 0, (D / 256) * KS_OUT, 32, 4, G, bid};
          pg8::EpiSlab E{SLAB_OUT, D, 32, nullptr, 0};
          pg8::gemm_phase<pg8::EpiSlab, pg8::SplitOrder, PG8_ALIGN, PG8_SP2>(lds, g, S, E); }
    }
    SEAM(6);

    if (IN(7)) {
        PHASE_ARGS();
        PHASE_IDS();
        const float* gpost = AIN(I_GPOSTMIX); const float* gpre = AIN(I_GPREMLP);
        for (int r = gw; r < MPAD; r += NGW) {
            GAS v2u* o8 = (GAS v2u*)(HN + (size_t)r * D) + lane;
            if (r >= MR) {
#pragma unroll
                for (int j = 0; j < 8; ++j) o8[64 * j] = (v2u){0u, 0u};
                continue; }
            const float* xr = (r < MP) ? AIN(I_XP) + (size_t)r * D : AIN(I_XS) + (size_t)(r - MP) * D;
            const float* mrow = MOD + (size_t)((r < MP) ? (r >> 11) : (4 + r - MP)) * NMOD;
            f32x4 v[8]; float ss = 0.f;
            if (r < MP) {
#pragma unroll
                for (int j = 0; j < 8; ++j) v[j] = *((const f32x4*)(MIX + (size_t)r * D) + lane + 64 * j);
            } else {
#pragma unroll
                for (int j = 0; j < 8; ++j) v[j] = (f32x4){0.f, 0.f, 0.f, 0.f};
#pragma unroll 1
                for (int k = 0; k < KS_OUT; ++k) { const f32x4* sp = (const f32x4*)(SLAB_OUT + ((size_t)k * 128 + (r - MP)) * D) + lane;
#pragma unroll
                    for (int j = 0; j < 8; ++j) v[j] += sp[64 * j]; }
            }
#pragma unroll
            for (int j = 0; j < 8; ++j) ss += (v[j][0] * v[j][0] + v[j][1] * v[j][1]) + (v[j][2] * v[j][2] + v[j][3] * v[j][3]);
            const float rinv = rsqrtf(wave_sum(ss) * (1.f / D) + EPS);
            float ss1 = 0.f;
#pragma unroll
            for (int j = 0; j < 8; ++j) { const int c = 4 * lane + 256 * j;
                const f32x4 x = *(const f32x4*)(xr + c), gp = *(const f32x4*)(gpost + c), gt = *(const f32x4*)(mrow + 2 * D + c);
                const f32x4 x1 = x + gt * (v[j] * rinv * gp);
                *(f32x4*)(out + O_YP + (size_t)r * D + c) = x1; v[j] = x1;
                ss1 += (x1[0] * x1[0] + x1[1] * x1[1]) + (x1[2] * x1[2] + x1[3] * x1[3]); }
            const float rinv1 = rsqrtf(wave_sum(ss1) * (1.f / D) + EPS);
#pragma unroll
            for (int j = 0; j < 8; ++j) { const int c = 4 * lane + 256 * j;
                const f32x4 g = *(const f32x4*)(gpre + c), sh = *(const f32x4*)(mrow + 3 * D + c), sc = *(const f32x4*)(mrow + 4 * D + c);
                const f32x4 h = v[j] * rinv1 * g * (sc + 1.f) + sh;
                o8[64 * j] = (v2u){pk2(h[0], h[1]), pk2(h[2], h[3])}; }
        }
    }
    SEAM(7);

    if (IN(8)) {
        PHASE_ARGS();
        { pg8::Gemm g{HN, WUP_T, D, D / 64}; pg8::FullOrder S; S.init(MP / 256, DFF / 256, G, bid);
          pg8::EpiBf16<2> E{UB, DFF};
          pg8::gemm_phase<pg8::EpiBf16<2>, pg8::FullOrder, PG8_ALIGN, PG8_SP2>(lds, g, S, E); }
        { pg8::Gemm g{HN, WUP_T, D, D / 64 / KS_UP}; pg8::SplitOrder S{0, 0, (DFF / 256) * KS_UP, 32, 3, G, bid};
          pg8::EpiSlab E{SLAB_UP, DFF, 32, nullptr, 0};
          pg8::gemm_phase<pg8::EpiSlab, pg8::SplitOrder, PG8_ALIGN, PG8_SP2>(lds, g, S, E); }
    }
    SEAM(8);

    if (IN(9)) {
        PHASE_ARGS();
        PHASE_IDS();
        const int n4 = MS * DFF / 4;
        for (int i = bid * NTHR + tid; i < 2 * n4; i += G * NTHR) {
            const int e = 4 * i, r = e / DFF, c = e - r * DFF;
            f32x4 s = (f32x4){0.f, 0.f, 0.f, 0.f};
            if (r < MS) {
#pragma unroll
                for (int k = 0; k < KS_UP; ++k) s += *(const f32x4*)(SLAB_UP + ((size_t)k * 128 + r) * DFF + c);
#pragma unroll
                for (int q = 0; q < 4; ++q) { const float a = fmaxf(s[q], 0.f); s[q] = a * a; }
            }
            *(GAS v2u*)(UB + (size_t)(MP + r) * DFF + c) = (v2u){pk2(s[0], s[1]), pk2(s[2], s[3])};
        }
    }
    SEAM(9);

    if (IN(10)) {
        PHASE_ARGS();
        { pg8::Gemm g{UB, WDOWN_T, DFF, DFF / 64}; pg8::FullOrder S; S.init(MP / 256, D / 256, G, bid);
          pg8::EpiF32 E{MLP, D};
          pg8::gemm_phase<pg8::EpiF32, pg8::FullOrder, PG8_ALIGN, PG8_SP2>(lds, g, S, E); }
        { pg8::Gemm g{UB, WDOWN_T, DFF, DFF / 64 / KS_DOWN}; pg8::SplitOrder S{0, 0, (D / 256) * KS_DOWN, 32, 5, G, bid};
          pg8::EpiSlab E{SLAB_DOWN, D, 32, nullptr, 0};
          pg8::gemm_phase<pg8::EpiSlab, pg8::SplitOrder, PG8_ALIGN, PG8_SP2>(lds, g, S, E); }
    }
    SEAM(10);

    if (IN(11)) {
        PHASE_ARGS();
        PHASE_IDS();
        const float* gpost = AIN(I_GPOSTMLP);
        for (int r = gw; r < MR; r += NGW) {
            const float* mrow = MOD + (size_t)((r < MP) ? (r >> 11) : (4 + r - MP)) * NMOD;
            f32x4 v[8]; float ss = 0.f;
            if (r < MP) {
#pragma unroll
                for (int j = 0; j < 8; ++j) v[j] = *((const f32x4*)(MLP + (size_t)r * D) + lane + 64 * j);
            } else {
#pragma unroll
                for (int j = 0; j < 8; ++j) v[j] = (f32x4){0.f, 0.f, 0.f, 0.f};
#pragma unroll 1
                for (int k = 0; k < KS_DOWN; ++k) { const f32x4* sp = (const f32x4*)(SLAB_DOWN + ((size_t)k * 128 + (r - MP)) * D) + lane;
#pragma unroll
                    for (int j = 0; j < 8; ++j) v[j] += sp[64 * j]; }
            }
#pragma unroll
            for (int j = 0; j < 8; ++j) ss += (v[j][0] * v[j][0] + v[j][1] * v[j][1]) + (v[j][2] * v[j][2] + v[j][3] * v[j][3]);
            const float rinv = rsqrtf(wave_sum(ss) * (1.f / D) + EPS);
#pragma unroll
            for (int j = 0; j < 8; ++j) { const int c = 4 * lane + 256 * j;
                float* yp = out + O_YP + (size_t)r * D + c;
                const f32x4 x1 = *(const f32x4*)yp, gp = *(const f32x4*)(gpost + c), gt = *(const f32x4*)(mrow + 5 * D + c);
                *(f32x4*)yp = x1 + gt * (v[j] * rinv * gp); }
        }
    }
#undef IN
#undef SEAM
}

extern "C" void kernel_launch(void* const* d_in, const int* in_sizes, int n_in, void* d_out, int out_size, void* d_ws, size_t ws_size, hipStream_t stream) {
    static int grid = 0;
    if (grid == 0) {
        if (n_in != 25 || (size_t)out_size != O_END || ws_size < WS_END) { fprintf(stderr, "kernel_launch: unexpected problem (n_in %d out %d ws %zu)\n", n_in, out_size, ws_size); grid = -1; return; }
        int dev = 0, cus = 0;
        if (hipGetDevice(&dev) != hipSuccess || hipDeviceGetAttribute(&cus, hipDeviceAttributeMultiprocessorCount, dev) != hipSuccess) { grid = -1; return; }
        if (hipFuncSetAttribute((const void*)hymba_fwd, hipFuncAttributeMaxDynamicSharedMemorySize, LDS_BYTES) != hipSuccess) { fprintf(stderr, "kernel_launch: hipFuncSetAttribute failed\n"); grid = -1; return; }
        int per_cu = 0;
        if (hipOccupancyMaxActiveBlocksPerMultiprocessor(&per_cu, (const void*)hymba_fwd, NTHR, LDS_BYTES) != hipSuccess || per_cu < 1) { fprintf(stderr, "kernel_launch: occupancy query says %d blocks per CU\n", per_cu); }
        (void)hipGetLastError();
        grid = cus;
    }
    if (grid < 0) return;
    if (hipMemsetAsync((char*)d_ws + WS_CTL, 0, CTL_ZERO_BYTES, stream) != hipSuccess) return;
    Args a{};
    for (int i = 0; i < 25; ++i) a.in[i] = (const float*)d_in[i];
    a.out = (float*)d_out; a.ws = (unsigned char*)d_ws;
    if (N_LAUNCHES == 1) {
        a.ph_lo = 0; a.ph_hi = PER_PHASE;
        hipLaunchKernelGGL(hymba_fwd, dim3(grid), dim3(NTHR), LDS_BYTES, stream, a);
    } else {
        for (int li = 0; li < PER_PHASE; ++li) { a.ph_lo = li; a.ph_hi = li + 1; hipLaunchKernelGGL(hymba_fwd, dim3(grid), dim3(NTHR), LDS_BYTES, stream, a); }
    }
}
```

```cpp
#include <hip/hip_runtime.h>
#include <cstdio>
#include <cstdint>

#ifndef MK_N_LAUNCHES
#define MK_N_LAUNCHES 1
#endif

namespace pg8 {
#define PG8_LAS __attribute__((address_space(3)))
typedef unsigned short bf16_t;
typedef short bf16x8 __attribute__((ext_vector_type(8)));
typedef float f32x4 __attribute__((ext_vector_type(4)));
typedef unsigned u32x4 __attribute__((ext_vector_type(4)));
constexpr int BM = 256, BK = 64, HALF = 128, HTB = HALF * BK * 2, STAGE_BYTES = 8 * HTB, NXCD = 8, WGM = 8;

__host__ __device__ __forceinline__ int lds_byte(int r, int c) { const int st = (r >> 4) * 2 + (c >> 5), rr = r & 15, cc = c & 31, ob = rr * 64 + cc * 2; return st * 1024 + (ob ^ (((ob >> 9) & 1) << 5)); }
__host__ __device__ __forceinline__ void stage_rc(int b, int& R, int& C) { const int st = b / 1024, sb = b % 1024, swz = sb ^ (((sb >> 9) & 1) << 5); R = (st >> 1) * 16 + swz / 64; C = (st & 1) * 32 + (swz % 64) / 2; }
__host__ __device__ __forceinline__ int perm32(int rho) { const int n = rho >> 4, i = rho & 15; return 8 * (i >> 2) + 4 * n + (i & 3); }

struct Unit { int pm, pn, ks; };
struct Gemm { const bf16_t* A; const bf16_t* Bt; int K, nt; };

struct FullOrder {
    int nM, nN, nwg, G, c;
    __device__ void init(int nM_, int nN_, int G_, int c_) { nM = nM_; nN = nN_; nwg = nM * nN; G = G_; c = c_; }
    __device__ bool next(int i, Unit& u) const {
        const long L = (long)i * G + c; if (L >= nwg) return false;
        int wgid = (int)L; { const int q = nwg / NXCD, r = nwg % NXCD, xcd = wgid % NXCD, off = wgid / NXCD; wgid = (xcd < r ? xcd * (q + 1) : r * (q + 1) + (xcd - r) * q) + off; }
        const int nig = WGM * nN, gid = wgid / nig, fm = gid * WGM, gsz = (nM - fm) < WGM ? (nM - fm) : WGM;
        u.pm = fm + ((wgid % nig) % gsz); u.pn = (wgid % nig) / gsz; u.ks = 0; return true;
    }
};
struct SplitOrder {
    int n_a, pn_a, n_b, pm_b, lks, G, c;
    __device__ bool next(int i, Unit& u) const {
        const int L = i * G + c; const int mask = (1 << lks) - 1;
        if (L < n_a) { u.pm = L >> lks; u.pn = pn_a; u.ks = L & mask; return true; }
        const int v = L - n_a; if (v >= n_b) return false;
        u.pm = pm_b; u.pn = v >> lks; u.ks = v & mask; return true;
    }
};

__device__ __forceinline__ unsigned cvt_pk_bf16(float lo, float hi) { unsigned r; asm volatile("v_cvt_pk_bf16_f32 %0, %1, %2" : "=v"(r) : "v"(lo), "v"(hi)); return r; }

template <int ACT  > struct EpiBf16 {
    static constexpr bool PERM = true;
    bf16_t* O; int ldc;
    __device__ __forceinline__ void operator()(const f32x4 (&acc)[2][2][4][2], const Unit& u, int wr, int wc, int fr, int fq) const {
        const int row0 = u.pm * BM + wr * 64 + fr, col0 = u.pn * BM + wc * 32 + 8 * fq;
#pragma unroll
        for (int ai = 0; ai < 2; ++ai)
#pragma unroll
            for (int m = 0; m < 4; ++m) { bf16_t* rowp = O + (size_t)(row0 + ai * HALF + m * 16) * ldc + col0;
#pragma unroll
                for (int bj = 0; bj < 2; ++bj) { f32x4 v0 = acc[ai][bj][m][0], v1 = acc[ai][bj][m][1];
                    if (ACT == 2) {
#pragma unroll
                        for (int e = 0; e < 4; ++e) { const float a = fmaxf(v0[e], 0.f), b = fmaxf(v1[e], 0.f); v0[e] = a * a; v1[e] = b * b; } }
                    u32x4 w; w.x = cvt_pk_bf16(v0[0], v0[1]); w.y = cvt_pk_bf16(v0[2], v0[3]); w.z = cvt_pk_bf16(v1[0], v1[1]); w.w = cvt_pk_bf16(v1[2], v1[3]);
                    *(u32x4*)(rowp + bj * HALF) = w; } }
    }
};
struct EpiF32 {
    static constexpr bool PERM = false;
    float* C; int ldc;
    __device__ __forceinline__ void operator()(const f32x4 (&acc)[2][2][4][2], const Unit& u, int wr, int wc, int fr, int fq) const {
        const int row0 = u.pm * BM + wr * 64 + fr, col0 = u.pn * BM + wc * 32 + 4 * fq;
#pragma unroll
        for (int ai = 0; ai < 2; ++ai)
#pragma unroll
            for (int m = 0; m < 4; ++m) { float* rowp = C + (size_t)(row0 + ai * HALF + m * 16) * ldc + col0;
#pragma unroll
                for (int bj = 0; bj < 2; ++bj)
#pragma unroll
                    for (int n = 0; n < 2; ++n) *(f32x4*)(rowp + bj * HALF + n * 16) = acc[ai][bj][m][n]; }
    }
};
struct EpiSlab {
    static constexpr bool PERM = false;
    float* Sb; int ld_b; int pm_b; float* Sa; int rows_a;
    __device__ __forceinline__ void operator()(const f32x4 (&acc)[2][2][4][2], const Unit& u, int wr, int wc, int fr, int fq) const {
        if (u.pm == pm_b) {
            const int col0 = u.pn * BM + wc * 32 + 4 * fq;
#pragma unroll
            for (int m = 0; m < 4; ++m) { float* rowp = Sb + ((size_t)u.ks * 128 + (wr * 64 + m * 16 + fr)) * ld_b + col0;
#pragma unroll
                for (int bj = 0; bj < 2; ++bj)
#pragma unroll
                    for (int n = 0; n < 2; ++n) *(f32x4*)(rowp + bj * HALF + n * 16) = acc[0][bj][m][n]; }
        } else if (wc == 0) {
#pragma unroll
            for (int ai = 0; ai < 2; ++ai)
#pragma unroll
                for (int m = 0; m < 4; ++m) { float* rowp = Sa + ((size_t)u.ks * rows_a + (u.pm * BM + ai * HALF + wr * 64 + m * 16 + fr)) * 32 + 4 * fq;
#pragma unroll
                    for (int n = 0; n < 2; ++n) *(f32x4*)(rowp + n * 16) = acc[ai][0][m][n]; }
        }
    }
};

template <class Epi, class Sched, bool ALIGN_EPI = false, bool SP2 = false>
__device__ __forceinline__ void gemm_phase(PG8_LAS unsigned char* lds, const Gemm g, const Sched& S, const Epi& E) {
    int tid_o = threadIdx.x; asm volatile("" : "+v"(tid_o));
    const int tid = tid_o, wid = __builtin_amdgcn_readfirstlane(tid >> 6), lane = tid & 63, wr = wid >> 2, wc = wid & 3, fr = lane & 15, fq = lane >> 4;
    const int K = g.K, nt = g.nt;
    unsigned voffA[2], voffB[2];
#pragma unroll
    for (int i = 0; i < 2; ++i) { int R, C; stage_rc(tid * 16 + i * 8192, R, C); const int Rb = Epi::PERM ? ((R & ~31) + perm32(R & 31)) : R;
        voffA[i] = (unsigned)(R * K + C) * 2u; voffB[i] = (unsigned)(Rb * K + C) * 2u; }
    const size_t kstep = (size_t)(BK * 2);
    const size_t hstep = (size_t)HALF * K * 2;
    const size_t tstep = 2 * hstep;
    const size_t sstep = (size_t)nt * kstep;
    const unsigned ldsw = (unsigned)wid * 1024u;
    const int aoff = lds_byte(wr * 64 + fr, fq * 8), boff = lds_byte(wc * 32 + fr, fq * 8);
#define PG8_SA(b, h) (((b) * 2 + (h)) * HTB)
#define PG8_SB(b, h) ((4 + (b) * 2 + (h)) * HTB)
#define PG8_STAGE(bufoff, gbase, voff) do { _Pragma("unroll") for (int _i = 0; _i < 2; ++_i) \
        __builtin_amdgcn_global_load_lds((const unsigned*)((const char*)(gbase) + (voff)[_i]), (PG8_LAS unsigned*)(lds + (bufoff) + ldsw + _i * 8192), 16, 0, 0); } while (0)
#define PG8_LDA(dst, b, h) do { _Pragma("unroll") for (int m = 0; m < 4; ++m) _Pragma("unroll") for (int k = 0; k < 2; ++k) dst[m][k] = *(const PG8_LAS bf16x8*)(lds + PG8_SA(b, h) + aoff + m * 2048 + k * 1024); } while (0)
#define PG8_LDB(dst, b, h) do { _Pragma("unroll") for (int n = 0; n < 2; ++n) _Pragma("unroll") for (int k = 0; k < 2; ++k) dst[n][k] = *(const PG8_LAS bf16x8*)(lds + PG8_SB(b, h) + boff + n * 2048 + k * 1024); } while (0)
#define PG8_MMA(ai, bj, At, Bt) do { __builtin_amdgcn_s_setprio(1); _Pragma("unroll") for (int m = 0; m < 4; ++m) _Pragma("unroll") for (int n = 0; n < 2; ++n) _Pragma("unroll") for (int k = 0; k < 2; ++k) \
        acc[ai][bj][m][n] = __builtin_amdgcn_mfma_f32_16x16x32_bf16(Bt[n][k], At[m][k], acc[ai][bj][m][n], 0, 0, 0); __builtin_amdgcn_s_setprio(0); } while (0)
#define PG8_WAIT_V(n) asm volatile("s_waitcnt vmcnt(" #n ")" ::: "memory")
#define PG8_WAIT_L(n) asm volatile("s_waitcnt lgkmcnt(" #n ")" ::: "memory")
#define PG8_BAR __builtin_amdgcn_s_barrier()
#define PG8_SCHED __builtin_amdgcn_sched_barrier(0)
    Unit cur, nxt; int ui = 0;
    if (!S.next(0, cur)) return;
    f32x4 acc[2][2][4][2];
#pragma unroll
    for (int a = 0; a < 2; ++a)
#pragma unroll
        for (int b = 0; b < 2; ++b)
#pragma unroll
            for (int m = 0; m < 4; ++m)
#pragma unroll
                for (int n = 0; n < 2; ++n) acc[a][b][m][n] = (f32x4){0.f, 0.f, 0.f, 0.f};
    bf16x8 At[4][2], B0[2][2], B1[2][2];
    const char* cA = (const char*)g.A + (size_t)cur.pm * tstep + (size_t)cur.ks * sstep; const char* cB = (const char*)g.Bt + (size_t)cur.pn * tstep + (size_t)cur.ks * sstep;
    if constexpr (SP2) {
        PG8_STAGE(PG8_SB(0, 0), cB, voffB); PG8_STAGE(PG8_SB(0, 1), cB + hstep, voffB); PG8_STAGE(PG8_SA(0, 0), cA, voffA); PG8_STAGE(PG8_SA(0, 1), cA + hstep, voffA);
        if (wr == 1) PG8_BAR;
        PG8_WAIT_V(2); PG8_BAR;
        PG8_STAGE(PG8_SB(1, 0), cB + kstep, voffB); PG8_STAGE(PG8_SA(1, 0), cA + kstep, voffA); PG8_STAGE(PG8_SB(1, 1), cB + hstep + kstep, voffB);
        PG8_WAIT_V(6); PG8_BAR;
    } else {
        PG8_STAGE(PG8_SB(0, 0), cB, voffB); PG8_STAGE(PG8_SA(0, 0), cA, voffA); PG8_STAGE(PG8_SB(0, 1), cB + hstep, voffB); PG8_STAGE(PG8_SA(0, 1), cA + hstep, voffA);
        if (wr == 1) PG8_BAR;
        PG8_WAIT_V(4); PG8_BAR;
        PG8_STAGE(PG8_SB(1, 0), cB + kstep, voffB); PG8_STAGE(PG8_SA(1, 0), cA + kstep, voffA); PG8_STAGE(PG8_SB(1, 1), cB + hstep + kstep, voffB);
        PG8_WAIT_V(6); PG8_BAR;
    }
    for (;;) {
        const bool has_next = S.next(ui + 1, nxt);
        const char* nA = has_next ? (const char*)g.A + (size_t)nxt.pm * tstep + (size_t)nxt.ks * sstep : cA; const char* nB = has_next ? (const char*)g.Bt + (size_t)nxt.pn * tstep + (size_t)nxt.ks * sstep : cB;
        for (int t = 0; t < nt; t += 2) {
            const bool last = (t == nt - 2);
            const char* a1 = cA + (size_t)(t + 1) * kstep;
            const char* a2 = last ? nA : cA + (size_t)(t + 2) * kstep; const char* b2 = last ? nB : cB + (size_t)(t + 2) * kstep;
            const char* a3 = a2 + kstep; const char* b3 = b2 + kstep;
            if constexpr (SP2) {
            PG8_LDB(B0, 0, 0); PG8_LDB(B1, 0, 1); PG8_SCHED; PG8_LDA(At, 0, 0); PG8_STAGE(PG8_SA(1, 1), a1 + hstep, voffA);
            PG8_WAIT_V(8); PG8_WAIT_L(0); PG8_BAR; PG8_MMA(0, 0, At, B0); PG8_MMA(0, 1, At, B1); PG8_BAR; PG8_SCHED;
            PG8_LDA(At, 0, 1); PG8_STAGE(PG8_SB(0, 0), b2, voffB); PG8_STAGE(PG8_SB(0, 1), b2 + hstep, voffB); PG8_STAGE(PG8_SA(0, 0), a2, voffA);
            PG8_WAIT_V(8); PG8_WAIT_L(0); PG8_BAR; PG8_MMA(1, 0, At, B0); PG8_MMA(1, 1, At, B1); PG8_BAR; PG8_SCHED;
            PG8_LDB(B0, 1, 0); PG8_LDB(B1, 1, 1); PG8_SCHED; PG8_LDA(At, 1, 0); PG8_STAGE(PG8_SA(0, 1), a2 + hstep, voffA);
            PG8_WAIT_V(8); PG8_WAIT_L(0); PG8_BAR; PG8_MMA(0, 0, At, B0); PG8_MMA(0, 1, At, B1); PG8_BAR; PG8_SCHED;
            PG8_LDA(At, 1, 1); PG8_STAGE(PG8_SB(1, 0), b3, voffB); PG8_STAGE(PG8_SB(1, 1), b3 + hstep, voffB); PG8_STAGE(PG8_SA(1, 0), a3, voffA);
            PG8_WAIT_V(8); PG8_WAIT_L(0); PG8_BAR; PG8_MMA(1, 0, At, B0); PG8_MMA(1, 1, At, B1); PG8_BAR; PG8_SCHED;
            } else {
            PG8_LDB(B0, 0, 0); PG8_SCHED; PG8_LDA(At, 0, 0); PG8_STAGE(PG8_SA(1, 1), a1 + hstep, voffA);
            PG8_WAIT_L(8); PG8_BAR; PG8_WAIT_L(0); PG8_MMA(0, 0, At, B0); PG8_BAR; PG8_SCHED;
            PG8_LDB(B1, 0, 1); PG8_STAGE(PG8_SB(0, 0), b2, voffB);
            PG8_BAR; PG8_WAIT_L(0); PG8_MMA(0, 1, At, B1); PG8_BAR;
            PG8_LDA(At, 0, 1); PG8_STAGE(PG8_SA(0, 0), a2, voffA);
            PG8_BAR; PG8_WAIT_L(0); PG8_MMA(1, 0, At, B0); PG8_BAR; PG8_SCHED;
            PG8_STAGE(PG8_SB(0, 1), b2 + hstep, voffB);
            PG8_WAIT_V(6); PG8_BAR; PG8_MMA(1, 1, At, B1); PG8_BAR;
            PG8_LDB(B0, 1, 0); PG8_SCHED; PG8_LDA(At, 1, 0); PG8_STAGE(PG8_SA(0, 1), a2 + hstep, voffA);
            PG8_WAIT_L(8); PG8_BAR; PG8_WAIT_L(0); PG8_MMA(0, 0, At, B0); PG8_BAR; PG8_SCHED;
            PG8_LDB(B1, 1, 1); PG8_STAGE(PG8_SB(1, 0), b3, voffB);
            PG8_BAR; PG8_WAIT_L(0); PG8_MMA(0, 1, At, B1); PG8_BAR;
            PG8_LDA(At, 1, 1); PG8_STAGE(PG8_SA(1, 0), a3, voffA);
            PG8_BAR; PG8_WAIT_L(0); PG8_MMA(1, 0, At, B0); PG8_BAR; PG8_SCHED;
            PG8_STAGE(PG8_SB(1, 1), b3 + hstep, voffB);
            PG8_WAIT_V(6); PG8_BAR; PG8_MMA(1, 1, At, B1); PG8_BAR;
            }
        }
        if constexpr (ALIGN_EPI) { if (wr == 0) PG8_BAR; }
        E(acc, cur, wr, wc, fr, fq);
        if (!has_next) break;
#pragma unroll
        for (int a = 0; a < 2; ++a)
#pragma unroll
            for (int b = 0; b < 2; ++b)
#pragma unroll
                for (int m = 0; m < 4; ++m)
#pragma unroll
                    for (int n = 0; n < 2; ++n) acc[a][b][m][n] = (f32x4){0.f, 0.f, 0.f, 0.f};
        cur = nxt; cA = nA; cB = nB; ++ui;
        if constexpr (ALIGN_EPI) { if (wr == 1) PG8_BAR; }
    }
    PG8_WAIT_V(0);
    if constexpr (!ALIGN_EPI) { if (wr == 0) PG8_BAR; }
    PG8_BAR;
#undef PG8_SA
#undef PG8_SB
#undef PG8_STAGE
#undef PG8_LDA
#undef PG8_LDB
#undef PG8_MMA
#undef PG8_WAIT_V
#undef PG8_WAIT_L
#undef PG8_BAR
#undef PG8_SCHED
}
}

#define PG8_SP2 true
#define PG8_ALIGN true

constexpr int NWAVES = 8, NTHR = NWAVES * 64;
constexpr int N_LAUNCHES = MK_N_LAUNCHES;
constexpr int PER_PHASE = 12;
constexpr int D = 2048, MP = 8192, MS = 128, MR = MP + MS, MPAD = 8448;
constexpr int NPROJ = 14368, LDP = 14592, DFF = 8192, NMOD = 12288, DCAT = 4096;
constexpr int C_Q = 0, C_F = 2048, C_I = 4096, C_G = 6144, C_Z = 8192, C_X = 10240, C_DT = 14336;
constexpr int KS_IN = 8, KS_OUT = 16, KS_UP = 8, KS_DOWN = 32;
constexpr float EPS = 1e-6f;
constexpr size_t O_YP = 0, O_HP = 17039360, O_SP = 18087936, O_CP = 19136512, O_HS = 19185664, O_SS = 52740096, O_CS = 86294528, O_END = 87867392;

constexpr size_t MiB = 1u << 20;
constexpr size_t WS_CTL = 0, CTL_ZERO_BYTES = 1 * MiB;
constexpr size_t WS_WIN = 1 * MiB;
constexpr size_t WS_WOUT = 58 * MiB;
constexpr size_t WS_WUP = 74 * MiB;
constexpr size_t WS_WDOWN = 106 * MiB;
constexpr size_t WS_MOD = 138 * MiB;
constexpr size_t WS_HN = 145 * MiB;
constexpr size_t WS_PROJ = 178 * MiB;
constexpr size_t WS_RA = 414 * MiB;
constexpr size_t WS_SLABDT = WS_RA + 57 * MiB, WS_DTB = WS_RA + 65 * MiB;
constexpr size_t WS_RB = 481 * MiB;
constexpr size_t WS_RC = 546 * MiB;
constexpr size_t WS_END = 611 * MiB;
constexpr int CW_BAR = 4096, CW_Q = 8192;

constexpr int RING_BYTES = 131072, LDSCTL_OFF = RING_BYTES, MISC_OFF = LDSCTL_OFF + 320, LDS_BYTES = 147456;

#define GAS __attribute__((address_space(1)))
#define LAS __attribute__((address_space(3)))
typedef unsigned short bf16;
typedef unsigned v4u __attribute__((ext_vector_type(4)));
typedef unsigned v2u __attribute__((ext_vector_type(2)));
typedef float f32x4 __attribute__((ext_vector_type(4)));
typedef float f32x2 __attribute__((ext_vector_type(2)));
typedef short bf16x8 __attribute__((ext_vector_type(8)));
typedef GAS unsigned gu32;
#define RLX_AGENT __ATOMIC_RELAXED, __HIP_MEMORY_SCOPE_AGENT
#define LDS_WAIT() asm volatile("s_waitcnt lgkmcnt(0)" ::: "memory")
#define VM_WAIT() asm volatile("s_waitcnt vmcnt(0)" ::: "memory")
__device__ __forceinline__ unsigned f2bf(float f) { unsigned u = __builtin_bit_cast(unsigned, f); return (u + 0x7fffu + ((u >> 16) & 1u)) >> 16; }
__device__ __forceinline__ unsigned pk2(float lo, float hi) { return f2bf(lo) | (f2bf(hi) << 16); }
__device__ __forceinline__ float bflo(unsigned w) { return __builtin_bit_cast(float, w << 16); }
__device__ __forceinline__ float bfhi(unsigned w) { return __builtin_bit_cast(float, w & 0xffff0000u); }
__device__ __forceinline__ float bf1(bf16 h) { return __builtin_bit_cast(float, (unsigned)h << 16); }
__device__ __forceinline__ float sigmoidf_(float x) { return __builtin_amdgcn_rcpf(1.f + __expf(-x)); }
__device__ __forceinline__ float siluf_(float x) { return x * sigmoidf_(x); }
__device__ __forceinline__ float softplusf_(float x) { return fmaxf(x, 0.f) + log1pf(__expf(-fabsf(x))); }
__device__ __forceinline__ float wave_sum(float v) {
#pragma unroll
    for (int o = 1; o < 64; o <<= 1) v += __shfl_xor(v, o);
    return v;
}

#define XB_TMO      128
#define XB_XCNT(j)  (256  + 64 * (j))
#define XB_XSUB(j)  (1280 + 64 * (j))
#define XB_XGEN(j)  (2304 + 64 * (j))
#define XB_TOP      3328
#define XB_TOPGEN   3392
#define XCD_BAR_WORDS 3456
#define XB_SPIN_CAP (1u << 22)

__device__ __forceinline__ unsigned xb_ld(unsigned* p)              { return __hip_atomic_load(p, __ATOMIC_RELAXED, __HIP_MEMORY_SCOPE_AGENT); }
__device__ __forceinline__ unsigned xb_add(unsigned* p, unsigned v) { return __hip_atomic_fetch_add(p, v, __ATOMIC_RELAXED, __HIP_MEMORY_SCOPE_AGENT); }
__device__ __forceinline__ unsigned xb_xcc_id() { return (unsigned)__builtin_amdgcn_s_getreg((3 << 11) | 20) & 0xFu; }
#define XB_SPIN(cond, bar) do { unsigned _sp = 0; while (cond) { __builtin_amdgcn_s_sleep(1); \
    if ((++_sp & 255u) == 0u) { if (xb_ld(&(bar)[XB_TMO])) break; if (_sp > XB_SPIN_CAP) { atomicAdd(&(bar)[XB_TMO], 1u); break; } } } } while (0)

struct XcdBarrier { unsigned* bar; unsigned x; volatile LAS unsigned* st; };

__device__ __forceinline__ XcdBarrier xcd_barrier_post(unsigned* bar, volatile LAS unsigned* st) {
    XcdBarrier b; b.bar = bar; b.x = xb_xcc_id(); b.st = st;
    if (threadIdx.x == 0) (void)xb_add(&bar[XB_XCNT(b.x)], 1u);
    return b;
}
__device__ __forceinline__ void xcd_barrier_complete(unsigned* bar, unsigned x, unsigned& nloc, unsigned& nx) {
    const unsigned G = gridDim.x * gridDim.y * gridDim.z;
    unsigned sum, cnt, mine, sp = 0u;
    for (;;) {
        sum = 0u; cnt = 0u; mine = 0u;
#pragma unroll
        for (unsigned j = 0; j < 16; ++j) { const unsigned c = xb_ld(&bar[XB_XCNT(j)]); sum += c; cnt += (c > 0u) ? 1u : 0u; mine = (j == x) ? c : mine; }
        if (sum == G) break;
        __builtin_amdgcn_s_sleep(1);
        if ((++sp & 255u) == 0u) { if (xb_ld(&bar[XB_TMO])) break; if (sp > XB_SPIN_CAP) { atomicAdd(&bar[XB_TMO], 1u); break; } }
    }
    nloc = mine > 0u ? mine : 1u; nx = cnt > 0u ? cnt : 1u;
}
__device__ __forceinline__ void xcd_barrier(const XcdBarrier& b) {
    asm volatile("s_waitcnt vmcnt(0)" ::: "memory");
    __syncthreads();
    if (threadIdx.x == 0) {
        unsigned* bar = b.bar;
        __builtin_amdgcn_s_waitcnt(0);
        unsigned nloc = b.st[0], nx = b.st[1];
        if (nloc == 0u) { xcd_barrier_complete(bar, b.x, nloc, nx); b.st[0] = nloc; b.st[1] = nx; }
        const unsigned old = xb_add(&bar[XB_XSUB(b.x)], 1u);
        const unsigned gen = old / nloc;
        if (old + 1u == (gen + 1u) * nloc) {
            __builtin_amdgcn_fence(__ATOMIC_RELEASE, "agent");
            asm volatile("s_waitcnt vmcnt(0)" ::: "memory");
            const unsigned og = xb_add(&bar[XB_TOP], 1u);
            const unsigned tg = og / nx;
            if (og + 1u == (tg + 1u) * nx) xb_add(&bar[XB_TOPGEN], 1u);
            else XB_SPIN(xb_ld(&bar[XB_TOPGEN]) == tg, bar);
            __builtin_amdgcn_fence(__ATOMIC_ACQUIRE, "agent");
            xb_add(&bar[XB_XGEN(b.x)], 1u);
            asm volatile("s_waitcnt vmcnt(0)" ::: "memory");
        } else {
            XB_SPIN(xb_ld(&bar[XB_XGEN(b.x)]) == gen, bar);
            __builtin_amdgcn_fence(__ATOMIC_ACQUIRE, "agent");
            asm volatile("s_waitcnt vmcnt(0)" ::: "memory");
        }
    }
    __syncthreads();
}

struct Args { const float* in[25]; float* out; unsigned char* ws; int ph_lo, ph_hi; };
enum { I_XP = 0, I_XS, I_CP, I_CS, I_SH, I_SS, I_SC, I_WADA, I_BADA, I_GPREMIX, I_GPOSTMIX, I_GPREMLP, I_GPOSTMLP, I_WIN, I_LB, I_HNORM, I_CONVW, I_CONVB, I_DTB, I_ALOG, I_DSKIP, I_SNORM, I_WOUT, I_WUP, I_WDOWN };

__device__ __forceinline__ void p0_transpose_item(const float* W, int K, int N, bf16* WT, LAS float* scr, int item, int lane) {
    const int nblk = N / 32, kb = item / nblk, nb = item % nblk, k0 = 64 * kb, n0 = 32 * nb;
#pragma unroll 8
    for (int i = 0; i < 32; ++i) { const int kk = 2 * i + (lane >> 5); scr[kk * 33 + (lane & 31)] = W[(size_t)(k0 + kk) * N + n0 + (lane & 31)]; }
    LDS_WAIT(); asm volatile("" ::: "memory");
    const int c = lane & 7;
#pragma unroll
    for (int j = 0; j < 4; ++j) { const int n = (lane >> 3) + 8 * j; const LAS float* s = scr + (8 * c) * 33 + n;
        v4u o; o.x = pk2(s[0 * 33], s[1 * 33]); o.y = pk2(s[2 * 33], s[3 * 33]); o.z = pk2(s[4 * 33], s[5 * 33]); o.w = pk2(s[6 * 33], s[7 * 33]);
        *(GAS v4u*)(WT + (size_t)(n0 + n) * K + k0 + 8 * c) = o; }
    LDS_WAIT(); asm volatile("" ::: "memory");
}

__device__ __forceinline__ void p0_adaln_job(const float* cp, const float* cs, const float* wada, const float* bada, float* mod, LAS float* red, int job, int wave, int lane, int tid) {
    const int n0 = job * 48;
    f32x4 acc[9][3];
#pragma unroll
    for (int a = 0; a < 9; ++a)
#pragma unroll
        for (int b = 0; b < 3; ++b) acc[a][b] = (f32x4){0.f, 0.f, 0.f, 0.f};
    const int kq = 8 * (lane >> 4), lr = lane & 15;
#pragma unroll 1
    for (int ks = 0; ks < 8; ++ks) {
        const int kk = wave * 256 + ks * 32 + kq;
        bf16x8 bfr[3];
#pragma unroll
        for (int nt = 0; nt < 3; ++nt) {
            const float* wp = wada + (size_t)kk * NMOD + n0 + nt * 16 + lr;
            float w[8];
#pragma unroll
            for (int j = 0; j < 8; ++j) w[j] = wp[(size_t)j * NMOD];
            v4u p; p.x = pk2(w[0], w[1]); p.y = pk2(w[2], w[3]); p.z = pk2(w[4], w[5]); p.w = pk2(w[6], w[7]);
            bfr[nt] = __builtin_bit_cast(bf16x8, p);
        }
#pragma unroll
        for (int mt = 0; mt < 9; ++mt) {
            const int m = mt * 16 + lr;
            f32x4 c0 = (f32x4){0.f, 0.f, 0.f, 0.f}, c1 = c0;
            if (m < 132) { const float* src = (m < 4) ? (cp + (size_t)m * D) : (cs + (size_t)(m - 4) * D); c0 = *(const f32x4*)(src + kk); c1 = *(const f32x4*)(src + kk + 4); }
            v4u p; p.x = pk2(siluf_(c0[0]), siluf_(c0[1])); p.y = pk2(siluf_(c0[2]), siluf_(c0[3])); p.z = pk2(siluf_(c1[0]), siluf_(c1[1])); p.w = pk2(siluf_(c1[2]), siluf_(c1[3]));
            const bf16x8 afr = __builtin_bit_cast(bf16x8, p);
#pragma unroll
            for (int nt = 0; nt < 3; ++nt) acc[mt][nt] = __builtin_amdgcn_mfma_f32_16x16x32_bf16(afr, bfr[nt], acc[mt][nt], 0, 0, 0);
        }
    }
    for (int r = 0; r < 8; ++r) {
        if (wave == r) {
#pragma unroll
            for (int mt = 0; mt < 9; ++mt)
#pragma unroll
                for (int nt = 0; nt < 3; ++nt)
#pragma unroll
                    for (int i = 0; i < 4; ++i) { const int idx = (mt * 16 + (lane >> 4) * 4 + i) * 48 + nt * 16 + lr; const float prev = (r == 0) ? 0.f : red[idx]; red[idx] = prev + acc[mt][nt][i]; }
        }
        __syncthreads();
    }
    for (int idx = tid; idx < 132 * 48; idx += NTHR) { const int m = idx / 48, c = idx - m * 48; mod[(size_t)m * NMOD + n0 + c] = red[idx] + bada[n0 + c]; }
    __syncthreads();
}

typedef float f32x16 __attribute__((ext_vector_type(16)));
typedef float f32x2_t __attribute__((ext_vector_type(2)));
typedef __bf16 bf16x2_t __attribute__((ext_vector_type(2)));
#define MFMA32(a, b, c) __builtin_amdgcn_mfma_f32_32x32x16_bf16((a), (b), (c), 0, 0, 0)
__device__ __forceinline__ int crow16(int reg, int h) { return (reg & 3) + 8 * (reg >> 2) + 4 * h; }
__device__ __forceinline__ unsigned cvtpk(float lo, float hi) { f32x2_t v = {lo, hi}; bf16x2_t b = __builtin_convertvector(v, bf16x2_t); return __builtin_bit_cast(unsigned, b); }
__device__ __forceinline__ bf16x8 frag16(const LAS unsigned char* base, int row, int rs, int kbyte) { return *(const LAS bf16x8*)(base + row * rs + kbyte); }
__device__ __forceinline__ bf16x8 fragperm(const LAS unsigned char* base, int row, int rs, int s0) { const v2u lo = *(const LAS v2u*)(base + row * rs + s0 * 2), hi = *(const LAS v2u*)(base + row * rs + s0 * 2 + 16); return __builtin_bit_cast(bf16x8, (v4u){lo.x, lo.y, hi.x, hi.y}); }
__device__ __forceinline__ bf16x8 pack8(const f32x16& x, int s) { return __builtin_bit_cast(bf16x8, (v4u){cvtpk(x[8 * s], x[8 * s + 1]), cvtpk(x[8 * s + 2], x[8 * s + 3]), cvtpk(x[8 * s + 4], x[8 * s + 5]), cvtpk(x[8 * s + 6], x[8 * s + 7])}); }
#ifndef PROBE_PHASE
#define PROBE_PHASE -1
#endif
#ifndef PROBE_REPS
#define PROBE_REPS 2
#endif
__device__ __forceinline__ int probe_nrep(int n) { asm volatile("" : "+s"(n)); return n; }
__global__ void __launch_bounds__(NTHR, 2) hymba_fwd(Args args) {
    extern __shared__ __attribute__((aligned(16))) unsigned char lds_raw[];
    LAS unsigned char* lds = (LAS unsigned char*)lds_raw;
    LAS float* Lf = (LAS float*)lds;
    volatile LAS unsigned* MISC = (volatile LAS unsigned*)(lds + MISC_OFF);
    const int G = gridDim.x, bid = blockIdx.x;
#define PHASE_IDS() int tid_o = threadIdx.x; asm volatile("" : "+v"(tid_o)); const int tid = tid_o, lane = tid & 63, wave = __builtin_amdgcn_readfirstlane(tid >> 6), gw = bid * NWAVES + wave, NGW = G * NWAVES; (void)lane; (void)gw; (void)NGW
    typedef const __attribute__((address_space(4))) Args* kargs_t;
#define PHASE_ARGS() kargs_t ap = (kargs_t)__builtin_amdgcn_kernarg_segment_ptr(); asm volatile("" : "+s"(ap)); unsigned char* ws = ap->ws; float* out = ap->out; (void)out; \
    bf16* WIN_T = (bf16*)(ws + WS_WIN); bf16* WOUT_T = (bf16*)(ws + WS_WOUT); bf16* WUP_T = (bf16*)(ws + WS_WUP); bf16* WDOWN_T = (bf16*)(ws + WS_WDOWN); \
    float* MOD = (float*)(ws + WS_MOD); bf16* HN = (bf16*)(ws + WS_HN); bf16* PROJ = (bf16*)(ws + WS_PROJ); bf16* UB = (bf16*)(ws + WS_PROJ); \
    float* SLAB_IN = (float*)(ws + WS_RA); float* SLAB_DT = (float*)(ws + WS_SLABDT); float* DTB = (float*)(ws + WS_DTB); \
    bf16* CAT = (bf16*)(ws + WS_RA); float* SLAB_UP = (float*)(ws + WS_RA); \
    float* OA_RAW = (float*)(ws + WS_RB); float* MIX = (float*)(ws + WS_RB); float* MLP = (float*)(ws + WS_RB); \
    float* Y_RAW = (float*)(ws + WS_RC); float* SLAB_OUT = (float*)(ws + WS_RC); float* SLAB_DOWN = (float*)(ws + WS_RC); \
    (void)WIN_T; (void)WOUT_T; (void)WUP_T; (void)WDOWN_T; (void)MOD; (void)HN; (void)PROJ; (void)UB; (void)SLAB_IN; (void)SLAB_DT; (void)DTB; (void)CAT; (void)SLAB_UP; (void)OA_RAW; (void)MIX; (void)MLP; (void)Y_RAW; (void)SLAB_OUT; (void)SLAB_DOWN
#define AIN(i) ((const float*)ap->in[i])
    kargs_t ap0 = (kargs_t)__builtin_amdgcn_kernarg_segment_ptr();
    gu32* ctl = (gu32*)(ap0->ws + WS_CTL);

    for (int u = threadIdx.x; u < (LDS_BYTES - LDSCTL_OFF) / 4; u += NTHR) ((LAS unsigned*)(lds + LDSCTL_OFF))[u] = 0u;
    __syncthreads();
    XcdBarrier bar; bar.bar = (unsigned*)(ctl + CW_BAR); bar.x = 0; bar.st = nullptr;
    if (N_LAUNCHES != PER_PHASE) bar = xcd_barrier_post((unsigned*)(ctl + CW_BAR), MISC + 8);
    const int lo = ap0->ph_lo, hi = ap0->ph_hi;
#define IN(k) (lo <= (k) && (k) < hi)
#if PROBE_PHASE >= 0
#define REPLOOP(k) for (int rep_ = 0, nr_ = probe_nrep((k) == PROBE_PHASE ? PROBE_REPS : 1); rep_ < nr_; ++rep_)
#define P4REP rep_
#else
#define REPLOOP(k)
#define P4REP 0
#endif
#define SEAM(k) do { if (IN(k) && IN((k) + 1)) xcd_barrier(bar); } while (0)

    if (IN(0)) REPLOOP(0) {
        PHASE_ARGS();
        PHASE_IDS();
        for (int job = bid; job < 256; job += G)
            p0_adaln_job(AIN(I_CP), AIN(I_CS), AIN(I_WADA), AIN(I_BADA), MOD, Lf, job, wave, lane, tid);
        LAS float* scr = Lf + wave * 4096;
        constexpr int IT_IN = (D / 64) * (NPROJ / 32), IT_OUT = (DCAT / 64) * (D / 32), IT_UP = (D / 64) * (DFF / 32), IT_DOWN = (DFF / 64) * (D / 32);
        constexpr int NITEMS = IT_IN + IT_OUT + IT_UP + IT_DOWN;
        for (int it = gw; it < NITEMS; it += NGW) {
            int r = it;
            if (r < IT_IN) { p0_transpose_item(AIN(I_WIN), D, NPROJ, WIN_T, scr, r, lane); continue; } r -= IT_IN;
            if (r < IT_OUT) { p0_transpose_item(AIN(I_WOUT), DCAT, D, WOUT_T, scr, r, lane); continue; } r -= IT_OUT;
            if (r < IT_UP) { p0_transpose_item(AIN(I_WUP), D, DFF, WUP_T, scr, r, lane); continue; } r -= IT_UP;
            p0_transpose_item(AIN(I_WDOWN), DFF, D, WDOWN_T, scr, r, lane);
        }
        { v4u z = (v4u){0u, 0u, 0u, 0u}; GAS v4u* p = (GAS v4u*)(WIN_T + (size_t)NPROJ * D); const int n16 = (LDP - NPROJ) * D * 2 / 16;
          for (int i = bid * NTHR + tid; i < n16; i += G * NTHR) p[i] = z; }
    }
    SEAM(0);

    if (IN(1)) REPLOOP(1) {
        PHASE_ARGS();
        PHASE_IDS();
        const float* gpre = AIN(I_GPREMIX);
        for (int r = gw; r < MPAD; r += NGW) {
            GAS v2u* o8 = (GAS v2u*)(HN + (size_t)r * D) + lane;
            if (r >= MR) {
#pragma unroll
                for (int j = 0; j < 8; ++j) o8[64 * j] = (v2u){0u, 0u};
                continue; }
            const float* xr = (r < MP) ? AIN(I_XP) + (size_t)r * D : AIN(I_XS) + (size_t)(r - MP) * D;
            const float* mrow = MOD + (size_t)((r < MP) ? (r >> 11) : (4 + r - MP)) * NMOD;
            f32x4 v[8]; float ss = 0.f;
#pragma unroll
            for (int j = 0; j < 8; ++j) { v[j] = *((const f32x4*)xr + lane + 64 * j); ss += (v[j][0] * v[j][0] + v[j][1] * v[j][1]) + (v[j][2] * v[j][2] + v[j][3] * v[j][3]); }
            const float rinv = rsqrtf(wave_sum(ss) * (1.f / D) + EPS);
#pragma unroll
            for (int j = 0; j < 8; ++j) { const int c = 4 * lane + 256 * j;
                const f32x4 g = *(const f32x4*)(gpre + c), sh = *(const f32x4*)(mrow + c), sc = *(const f32x4*)(mrow + D + c);
                const f32x4 h = v[j] * rinv * g * (sc + 1.f) + sh;
                o8[64 * j] = (v2u){pk2(h[0], h[1]), pk2(h[2], h[3])}; }
        }
    }
    SEAM(1);

    if (IN(2)) REPLOOP(2) {
        PHASE_ARGS();
        { pg8::Gemm g{HN, WIN_T, D, D / 64}; pg8::FullOrder S; S.init(MP / 256, 56, G, bid);
          pg8::EpiBf16<0> E{PROJ, LDP};
          pg8::gemm_phase<pg8::EpiBf16<0>, pg8::FullOrder, PG8_ALIGN, PG8_SP2>(lds, g, S, E); }
        { pg8::Gemm g{HN, WIN_T, D, D / 64 / KS_IN}; pg8::SplitOrder S{32 * KS_IN, 56, 57 * KS_IN, 32, 3, G, bid};
          pg8::EpiSlab E{SLAB_IN, LDP, 32, SLAB_DT, MP};
          pg8::gemm_phase<pg8::EpiSlab, pg8::SplitOrder, PG8_ALIGN, PG8_SP2>(lds, g, S, E); }
    }
    SEAM(2);

    if (IN(3)) REPLOOP(3) {
        PHASE_ARGS();
        PHASE_IDS();
        const int n4 = MS * LDP / 4;
        for (int i = bid * NTHR + tid; i < n4; i += G * NTHR) {
            const int e = 4 * i, r = e / LDP, c = e - r * LDP;
            f32x4 s = (f32x4){0.f, 0.f, 0.f, 0.f};
#pragma unroll
            for (int k = 0; k < KS_IN; ++k) s += *(const f32x4*)(SLAB_IN + ((size_t)k * 128 + r) * LDP + c);
            *(GAS v2u*)(PROJ + (size_t)(MP + r) * LDP + c) = (v2u){pk2(s[0], s[1]), pk2(s[2], s[3])};
        }
        const float* dtb = AIN(I_DTB);
        for (int i = bid * NTHR + tid; i < MR * 32; i += G * NTHR) {
            const int row = i >> 5, h = i & 31; float s = 0.f;
            if (row < MP) {
#pragma unroll
                for (int k = 0; k < KS_IN; ++k) s += SLAB_DT[((size_t)k * MP + row) * 32 + h];
            } else {
#pragma unroll
                for (int k = 0; k < KS_IN; ++k) s += SLAB_IN[((size_t)k * 128 + (row - MP)) * LDP + C_DT + h];
            }
            DTB[i] = softplusf_(s + dtb[h]);
        }
    }
    SEAM(3);

    if (IN(4)) REPLOOP(4) {
        PHASE_ARGS();
        PHASE_IDS();
        const float* lbl = AIN(I_LB);
        const float* convw = AIN(I_CONVW); const float* convb = AIN(I_CONVB);
        for (int u = bid; u < 128; u += G) {
            const int r = lane & 31, lh = lane >> 5, tq = wave, kp = lane;
            const int tt = wave >> 2, ct = wave & 3;
            if (u < 64) {
                const int b = u >> 4, h = u & 15;
                LAS unsigned char* QG = lds; LAS unsigned char* KG = lds + 17408; LAS unsigned char* KGT = lds + 34816; LAS unsigned char* VT = lds + 53248; LAS unsigned char* ST = lds + 71680;
                LAS float* EC = (LAS float*)(lds + 106496); LAS float* TOT = (LAS float*)(lds + 107008);
                for (int i = tid; i < 34816 / 16; i += NTHR) ((LAS v4u*)ST)[i] = (v4u){0u, 0u, 0u, 0u};
                const int k0 = 2 * kp;
                const float lb0 = sigmoidf_(lbl[h * 128 + k0] - lbl[D + h * 128 + k0]), lb1 = sigmoidf_(lbl[h * 128 + k0 + 1] - lbl[D + h * 128 + k0 + 1]);
                const int kt = wave >> 1, vt0 = 2 * (wave & 1);
                f32x16 accS[2];
#pragma unroll
                for (int i = 0; i < 2; ++i)
#pragma unroll
                    for (int e = 0; e < 16; ++e) accS[i][e] = 0.f;
                for (int c0 = 0; c0 < 2048; c0 += 64) {
                    const size_t row0 = (size_t)b * 2048 + c0;
                    unsigned qw[8], fw[8], vw[8];
                    { const GAS char* pq = (const GAS char*)(PROJ + (row0 + 8 * tq) * LDP + h * 128);
                      int lo = 4 * kp; asm volatile("" : "+v"(lo));
#pragma unroll
                      for (int i = 0; i < 8; ++i) { qw[i] = *(const GAS unsigned*)(pq + (i * LDP + C_Q) * 2 + lo); fw[i] = *(const GAS unsigned*)(pq + (i * LDP + C_F) * 2 + lo); vw[i] = *(const GAS unsigned*)(pq + (i * LDP + C_I) * 2 + lo); } }
                    float kk[2][8], cs[2][8];
#pragma unroll
                    for (int e = 0; e < 2; ++e) { const float lb = e ? lb1 : lb0; float run = 0.f;
#pragma unroll
                        for (int i = 0; i < 8; ++i) { const float x = fmaxf(e ? bfhi(fw[i]) : bflo(fw[i]), -30.f); const float ex = __expf(-x), sg = __builtin_amdgcn_rcpf(1.f + ex);
                            const float f = lb + (1.f - lb) * sg; kk[e][i] = (1.f - lb) * ex * sg; run += __logf(f); cs[e][i] = run; }
                        TOT[tq * 128 + k0 + e] = run; }
                    __syncthreads();
#pragma unroll
                    for (int e = 0; e < 2; ++e) { float off = 0.f;
#pragma unroll
                        for (int q = 0; q < 7; ++q) off += (q < tq) ? TOT[q * 128 + k0 + e] : 0.f;
#pragma unroll
                        for (int i = 0; i < 8; ++i) cs[e][i] += off; }
                    { unsigned kgt0[4], kgt1[4];
#pragma unroll
                      for (int i = 0; i < 8; i += 2) {
                          float qg[2][2], kg[2][2];
#pragma unroll
                          for (int d = 0; d < 2; ++d)
#pragma unroll
                              for (int e = 0; e < 2; ++e) { const float bb = cs[e][i + d], eb = __expf(bb), enb = __expf(-bb); const float qv = e ? bfhi(qw[i + d]) : bflo(qw[i + d]);
                                  qg[d][e] = siluf_(qv) * eb; kg[d][e] = kk[e][i + d] * enb; }
#pragma unroll
                          for (int d = 0; d < 2; ++d) { *(LAS unsigned*)(QG + (8 * tq + i + d) * 272 + k0 * 2) = cvtpk(qg[d][0], qg[d][1]); *(LAS unsigned*)(KG + (8 * tq + i + d) * 272 + k0 * 2) = cvtpk(kg[d][0], kg[d][1]); }
                          kgt0[i >> 1] = cvtpk(kg[0][0], kg[1][0]); kgt1[i >> 1] = cvtpk(kg[0][1], kg[1][1]); }
                      *(LAS v4u*)(KGT + (k0) * 144 + 16 * tq) = (v4u){kgt0[0], kgt0[1], kgt0[2], kgt0[3]};
                      *(LAS v4u*)(KGT + (k0 + 1) * 144 + 16 * tq) = (v4u){kgt1[0], kgt1[1], kgt1[2], kgt1[3]};
                      *(LAS v4u*)(VT + (k0) * 144 + 16 * tq) = (v4u){(vw[0] & 0xffffu) | (vw[1] << 16), (vw[2] & 0xffffu) | (vw[3] << 16), (vw[4] & 0xffffu) | (vw[5] << 16), (vw[6] & 0xffffu) | (vw[7] << 16)};
                      *(LAS v4u*)(VT + (k0 + 1) * 144 + 16 * tq) = (v4u){(vw[0] >> 16) | (vw[1] & 0xffff0000u), (vw[2] >> 16) | (vw[3] & 0xffff0000u), (vw[4] >> 16) | (vw[5] & 0xffff0000u), (vw[6] >> 16) | (vw[7] & 0xffff0000u)};
                      if (tq == 7) { EC[k0] = __expf(cs[0][7]); EC[k0 + 1] = __expf(cs[1][7]); } }
                    __syncthreads();
                    { f32x16 Xd, Xf, O;
#pragma unroll
                      for (int e = 0; e < 16; ++e) { Xd[e] = 0.f; Xf[e] = 0.f; O[e] = 0.f; }
#pragma unroll
                      for (int ks = 0; ks < 8; ++ks) { const bf16x8 bq = frag16(QG, 32 * tt + r, 272, 32 * ks + 16 * lh), ad = frag16(KG, 32 * tt + r, 272, 32 * ks + 16 * lh);
                          Xd = MFMA32(ad, bq, Xd);
                          if (tt) { const bf16x8 af = frag16(KG, r, 272, 32 * ks + 16 * lh); Xf = MFMA32(af, bq, Xf); } }
#pragma unroll
                      for (int e = 0; e < 16; ++e) Xd[e] = (crow16(e, lh) <= r) ? Xd[e] : 0.f;
#pragma unroll
                      for (int st = 0; st < 2; ++st) { const bf16x8 xs = pack8(Xd, st); const bf16x8 bv = fragperm(VT, 32 * ct + r, 144, 32 * tt + 16 * st + 4 * lh); O = MFMA32(xs, bv, O); }
                      if (tt) {
#pragma unroll
                          for (int st = 0; st < 2; ++st) { const bf16x8 xs = pack8(Xf, st); const bf16x8 bv = fragperm(VT, 32 * ct + r, 144, 16 * st + 4 * lh); O = MFMA32(xs, bv, O); } }
#pragma unroll
                      for (int ks = 0; ks < 8; ++ks) { const bf16x8 a = frag16(QG, 32 * tt + r, 272, 32 * ks + 16 * lh), bs = frag16(ST, 32 * ct + r, 272, 32 * ks + 16 * lh); O = MFMA32(a, bs, O); }
                      GAS char* op = (GAS char*)(OA_RAW + (row0 + 32 * tt) * D + h * 128 + 32 * ct);
                      int lo = (4 * lh * D + r) * 4; asm volatile("" : "+v"(lo));
#pragma unroll
                      for (int e = 0; e < 16; ++e) *(GAS float*)(op + ((e & 3) + 8 * (e >> 2)) * D * 4 + lo) = O[e]; }
#pragma unroll
                    for (int i = 0; i < 2; ++i) {
#pragma unroll
                        for (int st = 0; st < 4; ++st) { const bf16x8 a = frag16(KGT, 32 * kt + r, 144, 32 * st + 16 * lh), bv = frag16(VT, 32 * (vt0 + i) + r, 144, 32 * st + 16 * lh); accS[i] = MFMA32(a, bv, accS[i]); }
#pragma unroll
                        for (int q = 0; q < 4; ++q) { const f32x4 e4 = *(const LAS f32x4*)(EC + 32 * kt + 8 * q + 4 * lh);
#pragma unroll
                            for (int j = 0; j < 4; ++j) accS[i][4 * q + j] *= e4[j]; } }
                    __syncthreads();
#pragma unroll
                    for (int i = 0; i < 2; ++i)
#pragma unroll
                        for (int q = 0; q < 4; ++q) *(LAS v2u*)(ST + (32 * (vt0 + i) + r) * 272 + (32 * kt + 8 * q + 4 * lh) * 2) = (v2u){cvtpk(accS[i][4 * q], accS[i][4 * q + 1]), cvtpk(accS[i][4 * q + 2], accS[i][4 * q + 3])};
                }
#pragma unroll
                for (int i = 0; i < 2; ++i)
#pragma unroll
                    for (int e = 0; e < 16; ++e) out[O_HP + ((size_t)(b * 16 + h) * 128 + 32 * kt + crow16(e, lh)) * 128 + 32 * (vt0 + i) + r] = accS[i][e];
                __syncthreads();
            } else {
                const int uu = u - 64, b = uu >> 4, hp = uu & 15, h0 = 2 * hp, g = hp >> 1;
                LAS unsigned char* Cm = lds; LAS unsigned char* Bm = lds + 17408; LAS unsigned char* BmT = lds + 34816; LAS unsigned char* xT = lds + 53248; LAS unsigned char* xwT = lds + 71680; LAS unsigned char* Hb = lds + 90112;
                LAS float* CUM = (LAS float*)(lds + 124928); LAS float* DTv = (LAS float*)(lds + 125440); LAS float* WSv = (LAS float*)(lds + 125952); LAS float* ET = (LAS float*)(lds + 126464); LAS float* ECs = (LAS float*)(lds + 126976);
                for (int i = tid; i < 34816 / 16; i += NTHR) ((LAS v4u*)Hb)[i] = (v4u){0u, 0u, 0u, 0u};
                const int colx = h0 * 64 + 2 * kp, colb = 2048 + g * 128 + 2 * kp, colc = 3072 + g * 128 + 2 * kp;
                float wx[2][4], wb[2][4], wc[2][4], bx[2], bb_[2], bc[2];
#pragma unroll
                for (int e = 0; e < 2; ++e) {
#pragma unroll
                    for (int j = 0; j < 4; ++j) { wx[e][j] = convw[j * 4096 + colx + e]; wb[e][j] = convw[j * 4096 + colb + e]; wc[e][j] = convw[j * 4096 + colc + e]; }
                    bx[e] = convb[colx + e]; bb_[e] = convb[colb + e]; bc[e] = convb[colc + e]; }
                const int hh = ct >> 1, pt = ct & 1;
                const float a_w = -__expf(AIN(I_ALOG)[h0 + (wave & 1)]);
                const float dsk = AIN(I_DSKIP)[h0 + hh];
                const int nt = wave >> 1, hs_ = wave & 1;
                f32x16 accH[2];
#pragma unroll
                for (int i = 0; i < 2; ++i)
#pragma unroll
                    for (int e = 0; e < 16; ++e) accH[i][e] = 0.f;
                for (int c0 = 0; c0 < 2048; c0 += 64) {
                    const size_t row0 = (size_t)b * 2048 + c0;
                    if (wave < 2) { const float dt = DTB[(row0 + lane) * 32 + h0 + wave]; float cum = dt * a_w;
#pragma unroll
                        for (int o = 1; o < 64; o <<= 1) { const float up = __shfl_up(cum, o); if (lane >= o) cum += up; }
                        const float tot = __shfl(cum, 63);
                        CUM[wave * 64 + lane] = cum; DTv[wave * 64 + lane] = dt; WSv[wave * 64 + lane] = __expf(tot - cum) * dt; ET[wave * 64 + lane] = __expf(cum);
                        if (lane == 0) ECs[wave] = __expf(tot); }
                    float xv[2][8];
                    { unsigned ux[11], ub[11], uc[11];
                      const int tb = c0 + 8 * tq - 3;
                      int lo = 4 * kp; asm volatile("" : "+v"(lo));
#pragma unroll
                      for (int j = 0; j < 11; ++j) { const bool ok = (tb + j) >= 0; const GAS char* pr = (const GAS char*)(PROJ + ((size_t)b * 2048 + (ok ? tb + j : 0)) * LDP + C_X);
                          ux[j] = *(const GAS unsigned*)(pr + (h0 * 64) * 2 + lo); ub[j] = *(const GAS unsigned*)(pr + (2048 + g * 128) * 2 + lo); uc[j] = *(const GAS unsigned*)(pr + (3072 + g * 128) * 2 + lo);
                          if (!ok) { ux[j] = 0u; ub[j] = 0u; uc[j] = 0u; } }
                      unsigned bt0[4], bt1[4], xt0[4], xt1[4];
#pragma unroll
                      for (int i = 0; i < 8; i += 2) {
                          float vb[2][2], vc[2][2];
#pragma unroll
                          for (int d = 0; d < 2; ++d)
#pragma unroll
                              for (int e = 0; e < 2; ++e) {
                                  float sx = bx[e], sb = bb_[e], sc = bc[e];
#pragma unroll
                                  for (int j = 0; j < 4; ++j) { sx += wx[e][j] * (e ? bfhi(ux[i + d + j]) : bflo(ux[i + d + j])); sb += wb[e][j] * (e ? bfhi(ub[i + d + j]) : bflo(ub[i + d + j])); sc += wc[e][j] * (e ? bfhi(uc[i + d + j]) : bflo(uc[i + d + j])); }
                                  xv[e][i + d] = siluf_(sx); vb[d][e] = siluf_(sb); vc[d][e] = siluf_(sc); }
#pragma unroll
                          for (int d = 0; d < 2; ++d) { *(LAS unsigned*)(Bm + (8 * tq + i + d) * 272 + 4 * kp) = cvtpk(vb[d][0], vb[d][1]); *(LAS unsigned*)(Cm + (8 * tq + i + d) * 272 + 4 * kp) = cvtpk(vc[d][0], vc[d][1]); }
                          bt0[i >> 1] = cvtpk(vb[0][0], vb[1][0]); bt1[i >> 1] = cvtpk(vb[0][1], vb[1][1]);
                          xt0[i >> 1] = cvtpk(xv[0][i], xv[0][i + 1]); xt1[i >> 1] = cvtpk(xv[1][i], xv[1][i + 1]); }
                      *(LAS v4u*)(BmT + (2 * kp) * 144 + 16 * tq) = (v4u){bt0[0], bt0[1], bt0[2], bt0[3]};
                      *(LAS v4u*)(BmT + (2 * kp + 1) * 144 + 16 * tq) = (v4u){bt1[0], bt1[1], bt1[2], bt1[3]};
                      *(LAS v4u*)(xT + (2 * kp) * 144 + 16 * tq) = (v4u){xt0[0], xt0[1], xt0[2], xt0[3]};
                      *(LAS v4u*)(xT + (2 * kp + 1) * 144 + 16 * tq) = (v4u){xt1[0], xt1[1], xt1[2], xt1[3]}; }
                    __syncthreads();
                    { const int hx = kp >> 5;
                      const f32x4 w0 = *(const LAS f32x4*)(WSv + hx * 64 + 8 * tq), w1 = *(const LAS f32x4*)(WSv + hx * 64 + 8 * tq + 4);
                      const float wv[8] = {w0[0], w0[1], w0[2], w0[3], w1[0], w1[1], w1[2], w1[3]};
                      unsigned a0[4], a1[4];
#pragma unroll
                      for (int i = 0; i < 8; i += 2) { a0[i >> 1] = cvtpk(xv[0][i] * wv[i], xv[0][i + 1] * wv[i + 1]); a1[i >> 1] = cvtpk(xv[1][i] * wv[i], xv[1][i + 1] * wv[i + 1]); }
                      *(LAS v4u*)(xwT + (2 * kp) * 144 + 16 * tq) = (v4u){a0[0], a0[1], a0[2], a0[3]};
                      *(LAS v4u*)(xwT + (2 * kp + 1) * 144 + 16 * tq) = (v4u){a1[0], a1[1], a1[2], a1[3]}; }
                    __syncthreads();
                    { f32x16 Xd, Xf, Y, Yi;
#pragma unroll
                      for (int e = 0; e < 16; ++e) { Xd[e] = 0.f; Xf[e] = 0.f; Y[e] = 0.f; Yi[e] = 0.f; }
#pragma unroll
                      for (int ks = 0; ks < 8; ++ks) { const bf16x8 bq = frag16(Cm, 32 * tt + r, 272, 32 * ks + 16 * lh), ad = frag16(Bm, 32 * tt + r, 272, 32 * ks + 16 * lh);
                          Xd = MFMA32(ad, bq, Xd);
                          if (tt) { const bf16x8 af = frag16(Bm, r, 272, 32 * ks + 16 * lh); Xf = MFMA32(af, bq, Xf); } }
                      const float cum_t = CUM[hh * 64 + 32 * tt + r];
#pragma unroll
                      for (int q = 0; q < 4; ++q) { const f32x4 c4 = *(const LAS f32x4*)(CUM + hh * 64 + 32 * tt + 8 * q + 4 * lh), d4 = *(const LAS f32x4*)(DTv + hh * 64 + 32 * tt + 8 * q + 4 * lh);
#pragma unroll
                          for (int j = 0; j < 4; ++j) { const int e = 4 * q + j; const float dec = __expf(fminf(cum_t - c4[j], 0.f)) * d4[j]; Xd[e] = (crow16(e, lh) <= r) ? Xd[e] * dec : 0.f; } }
#pragma unroll
                      for (int st = 0; st < 2; ++st) { const bf16x8 xs = pack8(Xd, st); const bf16x8 bv = fragperm(xT, hh * 64 + 32 * pt + r, 144, 32 * tt + 16 * st + 4 * lh); Y = MFMA32(xs, bv, Y); }
                      if (tt) {
#pragma unroll
                          for (int q = 0; q < 4; ++q) { const f32x4 c4 = *(const LAS f32x4*)(CUM + hh * 64 + 8 * q + 4 * lh), d4 = *(const LAS f32x4*)(DTv + hh * 64 + 8 * q + 4 * lh);
#pragma unroll
                              for (int j = 0; j < 4; ++j) { const int e = 4 * q + j; Xf[e] *= __expf(fminf(cum_t - c4[j], 0.f)) * d4[j]; } }
#pragma unroll
                          for (int st = 0; st < 2; ++st) { const bf16x8 xs = pack8(Xf, st); const bf16x8 bv = fragperm(xT, hh * 64 + 32 * pt + r, 144, 16 * st + 4 * lh); Y = MFMA32(xs, bv, Y); } }
#pragma unroll
                      for (int ks = 0; ks < 8; ++ks) { const bf16x8 a = frag16(Cm, 32 * tt + r, 272, 32 * ks + 16 * lh), bs = frag16(Hb, hh * 64 + 32 * pt + r, 272, 32 * ks + 16 * lh); Yi = MFMA32(a, bs, Yi); }
                      GAS char* yp = (GAS char*)(Y_RAW + (row0 + 32 * tt) * D + (h0 + hh) * 64 + 32 * pt);
                      int lo = (4 * lh * D + r) * 4; asm volatile("" : "+v"(lo));
#pragma unroll
                      for (int q = 0; q < 4; ++q) { const f32x4 e4 = *(const LAS f32x4*)(ET + hh * 64 + 32 * tt + 8 * q + 4 * lh);
                          const v2u xx = *(const LAS v2u*)(xT + (hh * 64 + 32 * pt + r) * 144 + (32 * tt + 8 * q + 4 * lh) * 2);
                          const float x4[4] = {bflo(xx.x), bfhi(xx.x), bflo(xx.y), bfhi(xx.y)};
#pragma unroll
                          for (int j = 0; j < 4; ++j) { const int e = 4 * q + j; *(GAS float*)(yp + (j + 8 * q) * D * 4 + lo) = Y[e] + e4[j] * Yi[e] + dsk * x4[j]; } } }
                    { const float ec = ECs[hs_];
#pragma unroll
                      for (int i = 0; i < 2; ++i) {
#pragma unroll
                          for (int e = 0; e < 16; ++e) accH[i][e] *= ec;
#pragma unroll
                          for (int st = 0; st < 4; ++st) { const bf16x8 a = frag16(BmT, 32 * nt + r, 144, 32 * st + 16 * lh), bv = frag16(xwT, hs_ * 64 + 32 * i + r, 144, 32 * st + 16 * lh); accH[i] = MFMA32(a, bv, accH[i]); } } }
                    __syncthreads();
#pragma unroll
                    for (int i = 0; i < 2; ++i)
#pragma unroll
                        for (int q = 0; q < 4; ++q) *(LAS v2u*)(Hb + (hs_ * 64 + 32 * i + r) * 272 + (32 * nt + 8 * q + 4 * lh) * 2) = (v2u){cvtpk(accH[i][4 * q], accH[i][4 * q + 1]), cvtpk(accH[i][4 * q + 2], accH[i][4 * q + 3])};
                }
#pragma unroll
                for (int i = 0; i < 2; ++i)
#pragma unroll
                    for (int q = 0; q < 4; ++q) *(f32x4*)(out + O_SP + ((size_t)(b * 32 + h0 + hs_) * 64 + 32 * i + r) * 128 + 32 * nt + 8 * q + 4 * lh) = (f32x4){accH[i][4 * q], accH[i][4 * q + 1], accH[i][4 * q + 2], accH[i][4 * q + 3]};
                __syncthreads();
            }
        }
        const int NU = 512 + 2048 + 1024 + 12 + 384;
        for (;;) {
            if (tid == 0) MISC[0] = 512u + __hip_atomic_fetch_add((unsigned*)(ctl + CW_Q + 64 * P4REP), 1u, __ATOMIC_RELAXED, __HIP_MEMORY_SCOPE_AGENT);
            __syncthreads();
            const int u = (int)MISC[0];
            __syncthreads();
            if (u >= NU) break;
            if (u < 512) {
            } else if (u < 512 + 2048) {
                const int uu = u - 512, s = uu >> 4, h = uu & 15;
                LAS float* qv = Lf; LAS float* fv = Lf + 128; LAS float* kv = Lf + 256; LAS float* iv = Lf + 384; LAS float* red = Lf + 512;
                if (tid < 128) { const int c = h * 128 + tid; const bf16* pr = PROJ + (size_t)(MP + s) * LDP + c;
                    const float lb = sigmoidf_(lbl[c] - lbl[D + c]);
                    const float sg = sigmoidf_(bf1(pr[C_F]));
                    qv[tid] = siluf_(bf1(pr[C_Q])); fv[tid] = lb + (1.f - lb) * sg; kv[tid] = (1.f - lb) * (1.f - sg); iv[tid] = bf1(pr[C_I]); }
                __syncthreads();
                const int v4 = (tid & 31) * 4, kr = tid >> 5;
                const f32x4 i4 = *(const LAS f32x4*)(iv + v4);
                f32x4 o4 = (f32x4){0.f, 0.f, 0.f, 0.f};
                const size_t sb = ((size_t)(s * 16 + h) * 128) * 128 + v4;
                const float* S0 = AIN(I_SH) + sb; float* S1 = out + O_HS + sb;
                f32x4 sv[8];
#pragma unroll
                for (int i = 0; i < 8; ++i) sv[i] = *(const f32x4*)(S0 + (size_t)(kr + 16 * i) * 128);
#pragma unroll
                for (int i = 0; i < 8; ++i) { const int k = kr + 16 * i; const f32x4 nv = sv[i] * fv[k] + i4 * kv[k]; *(f32x4*)(S1 + (size_t)k * 128) = nv; o4 += nv * qv[k]; }
                *(LAS f32x4*)(red + kr * 128 + v4) = o4;
                __syncthreads();
                if (tid < 128) { float o = 0.f;
#pragma unroll
                    for (int r = 0; r < 16; ++r) o += red[r * 128 + tid];
                    OA_RAW[(size_t)(MP + s) * D + h * 128 + tid] = o; }
                __syncthreads();
            } else if (u < 512 + 2048 + 1024) {
                const int uu = u - 2560, s = uu >> 3, g = uu & 7;
                LAS float* xc = Lf; LAS float* Bc = Lf + 256; LAS float* Cc = Lf + 384; LAS float* dtv = Lf + 512; LAS float* dav = Lf + 516;
                { int col; LAS float* dst;
                  if (tid < 256) { col = g * 256 + tid; dst = xc + tid; } else if (tid < 384) { col = 2048 + g * 128 + (tid - 256); dst = Bc + (tid - 256); } else { col = 3072 + g * 128 + (tid - 384); dst = Cc + (tid - 384); }
                  const float* sc = AIN(I_SC) + (size_t)s * 3 * 4096 + col;
                  const float raw = bf1(PROJ[(size_t)(MP + s) * LDP + C_X + col]);
                  const float val = convb[col] + convw[col] * sc[0] + convw[4096 + col] * sc[4096] + convw[8192 + col] * sc[8192] + convw[12288 + col] * raw;
                  *dst = siluf_(val);
                  if (tid < 4) { const int h = 4 * g + tid; const float dt = DTB[(size_t)(MP + s) * 32 + h]; dtv[tid] = dt; dav[tid] = __expf(dt * -__expf(AIN(I_ALOG)[h])); } }
                __syncthreads();
                const int n4 = (tid & 31) * 4, pr_ = tid >> 5;
                const f32x4 B4 = *(const LAS f32x4*)(Bc + n4), C4 = *(const LAS f32x4*)(Cc + n4);
#pragma unroll
                for (int hh = 0; hh < 4; ++hh) {
                    const int h = 4 * g + hh; const float dt = dtv[hh], dA = dav[hh], dsk = AIN(I_DSKIP)[h];
                    const size_t sb = ((size_t)(s * 32 + h) * 64) * 128 + n4;
                    const float* H0 = AIN(I_SS) + sb; float* H1 = out + O_SS + sb;
                    f32x4 hv[4];
#pragma unroll
                    for (int i = 0; i < 4; ++i) hv[i] = *(const f32x4*)(H0 + (size_t)(pr_ + 16 * i) * 128);
#pragma unroll
                    for (int i = 0; i < 4; ++i) { const int p = pr_ + 16 * i; const float x = xc[hh * 64 + p]; const f32x4 nv = hv[i] * dA + B4 * (dt * x); *(f32x4*)(H1 + (size_t)p * 128) = nv;
                        const f32x4 yc = nv * C4; float y = (yc[0] + yc[1]) + (yc[2] + yc[3]);
                        y += __shfl_xor(y, 1); y += __shfl_xor(y, 2); y += __shfl_xor(y, 4); y += __shfl_xor(y, 8); y += __shfl_xor(y, 16);
                        if ((tid & 31) == 0) Y_RAW[(size_t)(MP + s) * D + h * 64 + p] = y + dsk * x; }
                }
                __syncthreads();
            } else if (u < 512 + 2048 + 1024 + 12) {
                const int uu = u - 3584, b = uu / 3, j = uu - 3 * b;
                for (int c = tid; c < 4096; c += NTHR) out[O_CP + (size_t)(b * 3 + j) * 4096 + c] = bf1(PROJ[((size_t)b * 2048 + 2045 + j) * LDP + C_X + c]);
            } else {
                const int uu = u - 3596, s = uu / 3, j = uu - 3 * s;
                for (int c = tid; c < 4096; c += NTHR) out[O_CS + (size_t)(s * 3 + j) * 4096 + c] = (j < 2) ? AIN(I_SC)[(size_t)(s * 3 + j + 1) * 4096 + c] : bf1(PROJ[(size_t)(MP + s) * LDP + C_X + c]);
            }
        }
    }
    SEAM(4);

    if (IN(5)) REPLOOP(5) {
        PHASE_ARGS();
        PHASE_IDS();
        const float* hnorm = AIN(I_HNORM); const float* snorm = AIN(I_SNORM);
        for (int r = gw; r < MPAD; r += NGW) {
            bf16* crow = CAT + (size_t)r * DCAT;
            if (r >= MR) {
#pragma unroll
                for (int j = 0; j < 8; ++j) *((GAS v4u*)crow + lane + 64 * j) = (v4u){0u, 0u, 0u, 0u};
                continue; }
            const bf16* prow = PROJ + (size_t)r * LDP;
#pragma unroll
            for (int j = 0; j < 8; ++j) { const int c = 4 * lane + 256 * j;
                const f32x4 o = *(const f32x4*)(OA_RAW + (size_t)r * D + c);
                float ss = (o[0] * o[0] + o[1] * o[1]) + (o[2] * o[2] + o[3] * o[3]);
                ss += __shfl_xor(ss, 1); ss += __shfl_xor(ss, 2); ss += __shfl_xor(ss, 4); ss += __shfl_xor(ss, 8); ss += __shfl_xor(ss, 16);
                const float rinv = rsqrtf(ss * (1.f / 128.f) + EPS);
                const v2u gg = *(const GAS v2u*)(prow + C_G + c); const f32x4 hn = *(const f32x4*)(hnorm + c);
                const float g0 = siluf_(bflo(gg.x)), g1 = siluf_(bfhi(gg.x)), g2 = siluf_(bflo(gg.y)), g3 = siluf_(bfhi(gg.y));
                *(GAS v2u*)(crow + c) = (v2u){pk2(o[0] * rinv * hn[0] * g0, o[1] * rinv * hn[1] * g1), pk2(o[2] * rinv * hn[2] * g2, o[3] * rinv * hn[3] * g3)}; }
#pragma unroll
            for (int j = 0; j < 8; ++j) { const int c = 4 * lane + 256 * j;
                const f32x4 y = *(const f32x4*)(Y_RAW + (size_t)r * D + c);
                const v2u zz = *(const GAS v2u*)(prow + C_Z + c); const f32x4 sn = *(const f32x4*)(snorm + c);
                const float a0 = y[0] * siluf_(bflo(zz.x)), a1 = y[1] * siluf_(bfhi(zz.x)), a2 = y[2] * siluf_(bflo(zz.y)), a3 = y[3] * siluf_(bfhi(zz.y));
                const float ss = wave_sum((a0 * a0 + a1 * a1) + (a2 * a2 + a3 * a3));
                const float rinv = rsqrtf(ss * (1.f / 256.f) + EPS);
                *(GAS v2u*)(crow + D + c) = (v2u){pk2(a0 * rinv * sn[0], a1 * rinv * sn[1]), pk2(a2 * rinv * sn[2], a3 * rinv * sn[3])}; }
        }
    }
    SEAM(5);

    if (IN(6)) REPLOOP(6) {
        PHASE_ARGS();
        { pg8::Gemm g{CAT, WOUT_T, DCAT, DCAT / 64}; pg8::FullOrder S; S.init(MP / 256, D / 256, G, bid);
          pg8::EpiF32 E{MIX, D};
          pg8::gemm_phase<pg8::EpiF32, pg8::FullOrder, PG8_ALIGN, PG8_SP2>(lds, g, S, E); }
        { pg8::Gemm g{CAT, WOUT_T, DCAT, DCAT / 64 / KS_OUT}; pg8::SplitOrder S{0, 0, (D / 256) * KS_OUT, 32, 4, G, bid};
          pg8::EpiSlab E{SLAB_OUT, D, 32, nullptr, 0};
          pg8::gemm_phase<pg8::EpiSlab, pg8::SplitOrder, PG8_ALIGN, PG8_SP2>(lds, g, S, E); }
    }
    SEAM(6);

    if (IN(7)) REPLOOP(7) {
        PHASE_ARGS();
        PHASE_IDS();
        const float* gpost = AIN(I_GPOSTMIX); const float* gpre = AIN(I_GPREMLP);
        for (int r = gw; r < MPAD; r += NGW) {
            GAS v2u* o8 = (GAS v2u*)(HN + (size_t)r * D) + lane;
            if (r >= MR) {
#pragma unroll
                for (int j = 0; j < 8; ++j) o8[64 * j] = (v2u){0u, 0u};
                continue; }
            const float* xr = (r < MP) ? AIN(I_XP) + (size_t)r * D : AIN(I_XS) + (size_t)(r - MP) * D;
            const float* mrow = MOD + (size_t)((r < MP) ? (r >> 11) : (4 + r - MP)) * NMOD;
            f32x4 v[8]; float ss = 0.f;
            if (r < MP) {
#pragma unroll
                for (int j = 0; j < 8; ++j) v[j] = *((const f32x4*)(MIX + (size_t)r * D) + lane + 64 * j);
            } else {
#pragma unroll
                for (int j = 0; j < 8; ++j) v[j] = (f32x4){0.f, 0.f, 0.f, 0.f};
#pragma unroll 1
                for (int k = 0; k < KS_OUT; ++k) { const f32x4* sp = (const f32x4*)(SLAB_OUT + ((size_t)k * 128 + (r - MP)) * D) + lane;
#pragma unroll
                    for (int j = 0; j < 8; ++j) v[j] += sp[64 * j]; }
            }
#pragma unroll
            for (int j = 0; j < 8; ++j) ss += (v[j][0] * v[j][0] + v[j][1] * v[j][1]) + (v[j][2] * v[j][2] + v[j][3] * v[j][3]);
            const float rinv = rsqrtf(wave_sum(ss) * (1.f / D) + EPS);
            float ss1 = 0.f;
#pragma unroll
            for (int j = 0; j < 8; ++j) { const int c = 4 * lane + 256 * j;
                const f32x4 x = *(const f32x4*)(xr + c), gp = *(const f32x4*)(gpost + c), gt = *(const f32x4*)(mrow + 2 * D + c);
                const f32x4 x1 = x + gt * (v[j] * rinv * gp);
                *(f32x4*)(out + O_YP + (size_t)r * D + c) = x1; v[j] = x1;
                ss1 += (x1[0] * x1[0] + x1[1] * x1[1]) + (x1[2] * x1[2] + x1[3] * x1[3]); }
            const float rinv1 = rsqrtf(wave_sum(ss1) * (1.f / D) + EPS);
#pragma unroll
            for (int j = 0; j < 8; ++j) { const int c = 4 * lane + 256 * j;
                const f32x4 g = *(const f32x4*)(gpre + c), sh = *(const f32x4*)(mrow + 3 * D + c), sc = *(const f32x4*)(mrow + 4 * D + c);
                const f32x4 h = v[j] * rinv1 * g * (sc + 1.f) + sh;
                o8[64 * j] = (v2u){pk2(h[0], h[1]), pk2(h[2], h[3])}; }
        }
    }
    SEAM(7);

    if (IN(8)) REPLOOP(8) {
        PHASE_ARGS();
        { pg8::Gemm g{HN, WUP_T, D, D / 64}; pg8::FullOrder S; S.init(MP / 256, DFF / 256, G, bid);
          pg8::EpiBf16<2> E{UB, DFF};
          pg8::gemm_phase<pg8::EpiBf16<2>, pg8::FullOrder, PG8_ALIGN, PG8_SP2>(lds, g, S, E); }
        { pg8::Gemm g{HN, WUP_T, D, D / 64 / KS_UP}; pg8::SplitOrder S{0, 0, (DFF / 256) * KS_UP, 32, 3, G, bid};
          pg8::EpiSlab E{SLAB_UP, DFF, 32, nullptr, 0};
          pg8::gemm_phase<pg8::EpiSlab, pg8::SplitOrder, PG8_ALIGN, PG8_SP2>(lds, g, S, E); }
    }
    SEAM(8);

    if (IN(9)) REPLOOP(9) {
        PHASE_ARGS();
        PHASE_IDS();
        const int n4 = MS * DFF / 4;
        for (int i = bid * NTHR + tid; i < 2 * n4; i += G * NTHR) {
            const int e = 4 * i, r = e / DFF, c = e - r * DFF;
            f32x4 s = (f32x4){0.f, 0.f, 0.f, 0.f};
            if (r < MS) {
#pragma unroll
                for (int k = 0; k < KS_UP; ++k) s += *(const f32x4*)(SLAB_UP + ((size_t)k * 128 + r) * DFF + c);
#pragma unroll
                for (int q = 0; q < 4; ++q) { const float a = fmaxf(s[q], 0.f); s[q] = a * a; }
            }
            *(GAS v2u*)(UB + (size_t)(MP + r) * DFF + c) = (v2u){pk2(s[0], s[1]), pk2(s[2], s[3])};
        }
    }
    SEAM(9);

    if (IN(10)) REPLOOP(10) {
        PHASE_ARGS();
        { pg8::Gemm g{UB, WDOWN_T, DFF, DFF / 64}; pg8::FullOrder S; S.init(MP / 256, D / 256, G, bid);
          pg8::EpiF32 E{MLP, D};
          pg8::gemm_phase<pg8::EpiF32, pg8::FullOrder, PG8_ALIGN, PG8_SP2>(lds, g, S, E); }
        { pg8::Gemm g{UB, WDOWN_T, DFF, DFF / 64 / KS_DOWN}; pg8::SplitOrder S{0, 0, (D / 256) * KS_DOWN, 32, 5, G, bid};
          pg8::EpiSlab E{SLAB_DOWN, D, 32, nullptr, 0};
          pg8::gemm_phase<pg8::EpiSlab, pg8::SplitOrder, PG8_ALIGN, PG8_SP2>(lds, g, S, E); }
    }
    SEAM(10);

    if (IN(11)) REPLOOP(11) {
        PHASE_ARGS();
        PHASE_IDS();
        const float* gpost = AIN(I_GPOSTMLP);
        for (int r = gw; r < MR; r += NGW) {
            const float* mrow = MOD + (size_t)((r < MP) ? (r >> 11) : (4 + r - MP)) * NMOD;
            f32x4 v[8]; float ss = 0.f;
            if (r < MP) {
#pragma unroll
                for (int j = 0; j < 8; ++j) v[j] = *((const f32x4*)(MLP + (size_t)r * D) + lane + 64 * j);
            } else {
#pragma unroll
                for (int j = 0; j < 8; ++j) v[j] = (f32x4){0.f, 0.f, 0.f, 0.f};
#pragma unroll 1
                for (int k = 0; k < KS_DOWN; ++k) { const f32x4* sp = (const f32x4*)(SLAB_DOWN + ((size_t)k * 128 + (r - MP)) * D) + lane;
#pragma unroll
                    for (int j = 0; j < 8; ++j) v[j] += sp[64 * j]; }
            }
#pragma unroll
            for (int j = 0; j < 8; ++j) ss += (v[j][0] * v[j][0] + v[j][1] * v[j][1]) + (v[j][2] * v[j][2] + v[j][3] * v[j][3]);
            const float rinv = rsqrtf(wave_sum(ss) * (1.f / D) + EPS);
#pragma unroll
            for (int j = 0; j < 8; ++j) { const int c = 4 * lane + 256 * j;
                float* yp = out + O_YP + (size_t)r * D + c;
                const f32x4 x1 = *(const f32x4*)yp, gp = *(const f32x4*)(gpost + c), gt = *(const f32x4*)(mrow + 5 * D + c);
                *(f32x4*)yp = x1 + gt * (v[j] * rinv * gp); }
        }
    }
#undef IN
#undef SEAM
}

extern "C" void kernel_launch(void* const* d_in, const int* in_sizes, int n_in, void* d_out, int out_size, void* d_ws, size_t ws_size, hipStream_t stream) {
    static int grid = 0;
    if (grid == 0) {
        if (n_in != 25 || (size_t)out_size != O_END || ws_size < WS_END) { fprintf(stderr, "kernel_launch: unexpected problem (n_in %d out %d ws %zu)\n", n_in, out_size, ws_size); grid = -1; return; }
        int dev = 0, cus = 0;
        if (hipGetDevice(&dev) != hipSuccess || hipDeviceGetAttribute(&cus, hipDeviceAttributeMultiprocessorCount, dev) != hipSuccess) { grid = -1; return; }
        if (hipFuncSetAttribute((const void*)hymba_fwd, hipFuncAttributeMaxDynamicSharedMemorySize, LDS_BYTES) != hipSuccess) { fprintf(stderr, "kernel_launch: hipFuncSetAttribute failed\n"); grid = -1; return; }
        int per_cu = 0;
        if (hipOccupancyMaxActiveBlocksPerMultiprocessor(&per_cu, (const void*)hymba_fwd, NTHR, LDS_BYTES) != hipSuccess || per_cu < 1) { fprintf(stderr, "kernel_launch: occupancy query says %d blocks per CU\n", per_cu); }
        (void)hipGetLastError();
        grid = cus;
    }
    if (grid < 0) return;
    if (hipMemsetAsync((char*)d_ws + WS_CTL, 0, CTL_ZERO_BYTES, stream) != hipSuccess) return;
    Args a{};
    for (int i = 0; i < 25; ++i) a.in[i] = (const float*)d_in[i];
    a.out = (float*)d_out; a.ws = (unsigned char*)d_ws;
    if (N_LAUNCHES == 1) {
        a.ph_lo = 0; a.ph_hi = PER_PHASE;
        hipLaunchKernelGGL(hymba_fwd, dim3(grid), dim3(NTHR), LDS_BYTES, stream, a);
    } else {
        for (int li = 0; li < PER_PHASE; ++li) { a.ph_lo = li; a.ph_hi = li + 1; hipLaunchKernelGGL(hymba_fwd, dim3(grid), dim3(NTHR), LDS_BYTES, stream, a); }
    }
}
```

```cpp
#include <hip/hip_runtime.h>
#include <cstdio>
#include <cstdint>

#ifndef MK_N_LAUNCHES
#define MK_N_LAUNCHES 1
#endif

namespace pg8 {
#define PG8_LAS __attribute__((address_space(3)))
typedef unsigned short bf16_t;
typedef short bf16x8 __attribute__((ext_vector_type(8)));
typedef float f32x4 __attribute__((ext_vector_type(4)));
typedef unsigned u32x4 __attribute__((ext_vector_type(4)));
constexpr int BM = 256, BK = 64, HALF = 128, HTB = HALF * BK * 2, STAGE_BYTES = 8 * HTB, NXCD = 8, WGM = 8;

__host__ __device__ __forceinline__ int lds_byte(int r, int c) { const int st = (r >> 4) * 2 + (c >> 5), rr = r & 15, cc = c & 31, ob = rr * 64 + cc * 2; return st * 1024 + (ob ^ (((ob >> 9) & 1) << 5)); }
__host__ __device__ __forceinline__ void stage_rc(int b, int& R, int& C) { const int st = b / 1024, sb = b % 1024, swz = sb ^ (((sb >> 9) & 1) << 5); R = (st >> 1) * 16 + swz / 64; C = (st & 1) * 32 + (swz % 64) / 2; }
__host__ __device__ __forceinline__ int perm32(int rho) { const int n = rho >> 4, i = rho & 15; return 8 * (i >> 2) + 4 * n + (i & 3); }

struct Unit { int pm, pn, ks; };
struct Gemm { const bf16_t* A; const bf16_t* Bt; int K, nt; };

struct FullOrder {
    int nM, nN, nwg, G, c;
    __device__ void init(int nM_, int nN_, int G_, int c_) { nM = nM_; nN = nN_; nwg = nM * nN; G = G_; c = c_; }
    __device__ bool next(int i, Unit& u) const {
        const long L = (long)i * G + c; if (L >= nwg) return false;
        int wgid = (int)L; { const int q = nwg / NXCD, r = nwg % NXCD, xcd = wgid % NXCD, off = wgid / NXCD; wgid = (xcd < r ? xcd * (q + 1) : r * (q + 1) + (xcd - r) * q) + off; }
        const int nig = WGM * nN, gid = wgid / nig, fm = gid * WGM, gsz = (nM - fm) < WGM ? (nM - fm) : WGM;
        u.pm = fm + ((wgid % nig) % gsz); u.pn = (wgid % nig) / gsz; u.ks = 0; return true;
    }
};
struct SplitOrder {
    int n_a, pn_a, n_b, pm_b, lks, G, c;
    __device__ bool next(int i, Unit& u) const {
        const int L = i * G + c; const int mask = (1 << lks) - 1;
        if (L < n_a) { u.pm = L >> lks; u.pn = pn_a; u.ks = L & mask; return true; }
        const int v = L - n_a; if (v >= n_b) return false;
        u.pm = pm_b; u.pn = v >> lks; u.ks = v & mask; return true;
    }
};

__device__ __forceinline__ unsigned cvt_pk_bf16(float lo, float hi) { unsigned r; asm volatile("v_cvt_pk_bf16_f32 %0, %1, %2" : "=v"(r) : "v"(lo), "v"(hi)); return r; }

template <int ACT  > struct EpiBf16 {
    static constexpr bool PERM = true;
    bf16_t* O; int ldc;
    __device__ __forceinline__ void operator()(const f32x4 (&acc)[2][2][4][2], const Unit& u, int wr, int wc, int fr, int fq) const {
        const int row0 = u.pm * BM + wr * 64 + fr, col0 = u.pn * BM + wc * 32 + 8 * fq;
#pragma unroll
        for (int ai = 0; ai < 2; ++ai)
#pragma unroll
            for (int m = 0; m < 4; ++m) { bf16_t* rowp = O + (size_t)(row0 + ai * HALF + m * 16) * ldc + col0;
#pragma unroll
                for (int bj = 0; bj < 2; ++bj) { f32x4 v0 = acc[ai][bj][m][0], v1 = acc[ai][bj][m][1];
                    if (ACT == 2) {
#pragma unroll
                        for (int e = 0; e < 4; ++e) { const float a = fmaxf(v0[e], 0.f), b = fmaxf(v1[e], 0.f); v0[e] = a * a; v1[e] = b * b; } }
                    u32x4 w; w.x = cvt_pk_bf16(v0[0], v0[1]); w.y = cvt_pk_bf16(v0[2], v0[3]); w.z = cvt_pk_bf16(v1[0], v1[1]); w.w = cvt_pk_bf16(v1[2], v1[3]);
                    *(u32x4*)(rowp + bj * HALF) = w; } }
    }
};
struct EpiF32 {
    static constexpr bool PERM = false;
    float* C; int ldc;
    __device__ __forceinline__ void operator()(const f32x4 (&acc)[2][2][4][2], const Unit& u, int wr, int wc, int fr, int fq) const {
        const int row0 = u.pm * BM + wr * 64 + fr, col0 = u.pn * BM + wc * 32 + 4 * fq;
#pragma unroll
        for (int ai = 0; ai < 2; ++ai)
#pragma unroll
            for (int m = 0; m < 4; ++m) { float* rowp = C + (size_t)(row0 + ai * HALF + m * 16) * ldc + col0;
#pragma unroll
                for (int bj = 0; bj < 2; ++bj)
#pragma unroll
                    for (int n = 0; n < 2; ++n) *(f32x4*)(rowp + bj * HALF + n * 16) = acc[ai][bj][m][n]; }
    }
};
struct EpiSlab {
    static constexpr bool PERM = false;
    float* Sb; int ld_b; int pm_b; float* Sa; int rows_a;
    __device__ __forceinline__ void operator()(const f32x4 (&acc)[2][2][4][2], const Unit& u, int wr, int wc, int fr, int fq) const {
        if (u.pm == pm_b) {
            const int col0 = u.pn * BM + wc * 32 + 4 * fq;
#pragma unroll
            for (int m = 0; m < 4; ++m) { float* rowp = Sb + ((size_t)u.ks * 128 + (wr * 64 + m * 16 + fr)) * ld_b + col0;
#pragma unroll
                for (int bj = 0; bj < 2; ++bj)
#pragma unroll
                    for (int n = 0; n < 2; ++n) *(f32x4*)(rowp + bj * HALF + n * 16) = acc[0][bj][m][n]; }
        } else if (wc == 0) {
#pragma unroll
            for (int ai = 0; ai < 2; ++ai)
#pragma unroll
                for (int m = 0; m < 4; ++m) { float* rowp = Sa + ((size_t)u.ks * rows_a + (u.pm * BM + ai * HALF + wr * 64 + m * 16 + fr)) * 32 + 4 * fq;
#pragma unroll
                    for (int n = 0; n < 2; ++n) *(f32x4*)(rowp + n * 16) = acc[ai][0][m][n]; }
        }
    }
};

template <class Epi, class Sched, bool ALIGN_EPI = false, bool SP2 = false>
__device__ __forceinline__ void gemm_phase(PG8_LAS unsigned char* lds, const Gemm g, const Sched& S, const Epi& E) {
    int tid_o = threadIdx.x; asm volatile("" : "+v"(tid_o));
    const int tid = tid_o, wid = __builtin_amdgcn_readfirstlane(tid >> 6), lane = tid & 63, wr = wid >> 2, wc = wid & 3, fr = lane & 15, fq = lane >> 4;
    const int K = g.K, nt = g.nt;
    unsigned voffA[2], voffB[2];
#pragma unroll
    for (int i = 0; i < 2; ++i) { int R, C; stage_rc(tid * 16 + i * 8192, R, C); const int Rb = Epi::PERM ? ((R & ~31) + perm32(R & 31)) : R;
        voffA[i] = (unsigned)(R * K + C) * 2u; voffB[i] = (unsigned)(Rb * K + C) * 2u; }
    const size_t kstep = (size_t)(BK * 2);
    const size_t hstep = (size_t)HALF * K * 2;
    const size_t tstep = 2 * hstep;
    const size_t sstep = (size_t)nt * kstep;
    const unsigned ldsw = (unsigned)wid * 1024u;
    const int aoff = lds_byte(wr * 64 + fr, fq * 8), boff = lds_byte(wc * 32 + fr, fq * 8);
#define PG8_SA(b, h) (((b) * 2 + (h)) * HTB)
#define PG8_SB(b, h) ((4 + (b) * 2 + (h)) * HTB)
#define PG8_STAGE(bufoff, gbase, voff) do { _Pragma("unroll") for (int _i = 0; _i < 2; ++_i) \
        __builtin_amdgcn_global_load_lds((const unsigned*)((const char*)(gbase) + (voff)[_i]), (PG8_LAS unsigned*)(lds + (bufoff) + ldsw + _i * 8192), 16, 0, 0); } while (0)
#define PG8_LDA(dst, b, h) do { _Pragma("unroll") for (int m = 0; m < 4; ++m) _Pragma("unroll") for (int k = 0; k < 2; ++k) dst[m][k] = *(const PG8_LAS bf16x8*)(lds + PG8_SA(b, h) + aoff + m * 2048 + k * 1024); } while (0)
#define PG8_LDB(dst, b, h) do { _Pragma("unroll") for (int n = 0; n < 2; ++n) _Pragma("unroll") for (int k = 0; k < 2; ++k) dst[n][k] = *(const PG8_LAS bf16x8*)(lds + PG8_SB(b, h) + boff + n * 2048 + k * 1024); } while (0)
#define PG8_MMA(ai, bj, At, Bt) do { __builtin_amdgcn_s_setprio(1); _Pragma("unroll") for (int m = 0; m < 4; ++m) _Pragma("unroll") for (int n = 0; n < 2; ++n) _Pragma("unroll") for (int k = 0; k < 2; ++k) \
        acc[ai][bj][m][n] = __builtin_amdgcn_mfma_f32_16x16x32_bf16(Bt[n][k], At[m][k], acc[ai][bj][m][n], 0, 0, 0); __builtin_amdgcn_s_setprio(0); } while (0)
#define PG8_WAIT_V(n) asm volatile("s_waitcnt vmcnt(" #n ")" ::: "memory")
#define PG8_WAIT_L(n) asm volatile("s_waitcnt lgkmcnt(" #n ")" ::: "memory")
#define PG8_BAR __builtin_amdgcn_s_barrier()
#define PG8_SCHED __builtin_amdgcn_sched_barrier(0)
    Unit cur, nxt; int ui = 0;
    if (!S.next(0, cur)) return;
    f32x4 acc[2][2][4][2];
#pragma unroll
    for (int a = 0; a < 2; ++a)
#pragma unroll
        for (int b = 0; b < 2; ++b)
#pragma unroll
            for (int m = 0; m < 4; ++m)
#pragma unroll
                for (int n = 0; n < 2; ++n) acc[a][b][m][n] = (f32x4){0.f, 0.f, 0.f, 0.f};
    bf16x8 At[4][2], B0[2][2], B1[2][2];
    const char* cA = (const char*)g.A + (size_t)cur.pm * tstep + (size_t)cur.ks * sstep; const char* cB = (const char*)g.Bt + (size_t)cur.pn * tstep + (size_t)cur.ks * sstep;
    if constexpr (SP2) {
        PG8_STAGE(PG8_SB(0, 0), cB, voffB); PG8_STAGE(PG8_SB(0, 1), cB + hstep, voffB); PG8_STAGE(PG8_SA(0, 0), cA, voffA); PG8_STAGE(PG8_SA(0, 1), cA + hstep, voffA);
        if (wr == 1) PG8_BAR;
        PG8_WAIT_V(2); PG8_BAR;
        PG8_STAGE(PG8_SB(1, 0), cB + kstep, voffB); PG8_STAGE(PG8_SA(1, 0), cA + kstep, voffA); PG8_STAGE(PG8_SB(1, 1), cB + hstep + kstep, voffB);
        PG8_WAIT_V(6); PG8_BAR;
    } else {
        PG8_STAGE(PG8_SB(0, 0), cB, voffB); PG8_STAGE(PG8_SA(0, 0), cA, voffA); PG8_STAGE(PG8_SB(0, 1), cB + hstep, voffB); PG8_STAGE(PG8_SA(0, 1), cA + hstep, voffA);
        if (wr == 1) PG8_BAR;
        PG8_WAIT_V(4); PG8_BAR;
        PG8_STAGE(PG8_SB(1, 0), cB + kstep, voffB); PG8_STAGE(PG8_SA(1, 0), cA + kstep, voffA); PG8_STAGE(PG8_SB(1, 1), cB + hstep + kstep, voffB);
        PG8_WAIT_V(6); PG8_BAR;
    }
    for (;;) {
        const bool has_next = S.next(ui + 1, nxt);
        const char* nA = has_next ? (const char*)g.A + (size_t)nxt.pm * tstep + (size_t)nxt.ks * sstep : cA; const char* nB = has_next ? (const char*)g.Bt + (size_t)nxt.pn * tstep + (size_t)nxt.ks * sstep : cB;
        for (int t = 0; t < nt; t += 2) {
            const bool last = (t == nt - 2);
            const char* a1 = cA + (size_t)(t + 1) * kstep;
            const char* a2 = last ? nA : cA + (size_t)(t + 2) * kstep; const char* b2 = last ? nB : cB + (size_t)(t + 2) * kstep;
            const char* a3 = a2 + kstep; const char* b3 = b2 + kstep;
            if constexpr (SP2) {
            PG8_LDB(B0, 0, 0); PG8_LDB(B1, 0, 1); PG8_SCHED; PG8_LDA(At, 0, 0); PG8_STAGE(PG8_SA(1, 1), a1 + hstep, voffA);
            PG8_WAIT_V(8); PG8_WAIT_L(0); PG8_BAR; PG8_MMA(0, 0, At, B0); PG8_MMA(0, 1, At, B1); PG8_BAR; PG8_SCHED;
            PG8_LDA(At, 0, 1); PG8_STAGE(PG8_SB(0, 0), b2, voffB); PG8_STAGE(PG8_SB(0, 1), b2 + hstep, voffB); PG8_STAGE(PG8_SA(0, 0), a2, voffA);
            PG8_WAIT_V(8); PG8_WAIT_L(0); PG8_BAR; PG8_MMA(1, 0, At, B0); PG8_MMA(1, 1, At, B1); PG8_BAR; PG8_SCHED;
            PG8_LDB(B0, 1, 0); PG8_LDB(B1, 1, 1); PG8_SCHED; PG8_LDA(At, 1, 0); PG8_STAGE(PG8_SA(0, 1), a2 + hstep, voffA);
            PG8_WAIT_V(8); PG8_WAIT_L(0); PG8_BAR; PG8_MMA(0, 0, At, B0); PG8_MMA(0, 1, At, B1); PG8_BAR; PG8_SCHED;
            PG8_LDA(At, 1, 1); PG8_STAGE(PG8_SB(1, 0), b3, voffB); PG8_STAGE(PG8_SB(1, 1), b3 + hstep, voffB); PG8_STAGE(PG8_SA(1, 0), a3, voffA);
            PG8_WAIT_V(8); PG8_WAIT_L(0); PG8_BAR; PG8_MMA(1, 0, At, B0); PG8_MMA(1, 1, At, B1); PG8_BAR; PG8_SCHED;
            } else {
            PG8_LDB(B0, 0, 0); PG8_SCHED; PG8_LDA(At, 0, 0); PG8_STAGE(PG8_SA(1, 1), a1 + hstep, voffA);
            PG8_WAIT_L(8); PG8_BAR; PG8_WAIT_L(0); PG8_MMA(0, 0, At, B0); PG8_BAR; PG8_SCHED;
            PG8_LDB(B1, 0, 1); PG8_STAGE(PG8_SB(0, 0), b2, voffB);
            PG8_BAR; PG8_WAIT_L(0); PG8_MMA(0, 1, At, B1); PG8_BAR;
            PG8_LDA(At, 0, 1); PG8_STAGE(PG8_SA(0, 0), a2, voffA);
            PG8_BAR; PG8_WAIT_L(0); PG8_MMA(1, 0, At, B0); PG8_BAR; PG8_SCHED;
            PG8_STAGE(PG8_SB(0, 1), b2 + hstep, voffB);
            PG8_WAIT_V(6); PG8_BAR; PG8_MMA(1, 1, At, B1); PG8_BAR;
            PG8_LDB(B0, 1, 0); PG8_SCHED; PG8_LDA(At, 1, 0); PG8_STAGE(PG8_SA(0, 1), a2 + hstep, voffA);
            PG8_WAIT_L(8); PG8_BAR; PG8_WAIT_L(0); PG8_MMA(0, 0, At, B0); PG8_BAR; PG8_SCHED;
            PG8_LDB(B1, 1, 1); PG8_STAGE(PG8_SB(1, 0), b3, voffB);
            PG8_BAR; PG8_WAIT_L(0); PG8_MMA(0, 1, At, B1); PG8_BAR;
            PG8_LDA(At, 1, 1); PG8_STAGE(PG8_SA(1, 0), a3, voffA);
            PG8_BAR; PG8_WAIT_L(0); PG8_MMA(1, 0, At, B0); PG8_BAR; PG8_SCHED;
            PG8_STAGE(PG8_SB(1, 1), b3 + hstep, voffB);
            PG8_WAIT_V(6); PG8_BAR; PG8_MMA(1, 1, At, B1); PG8_BAR;
            }
        }
        if constexpr (ALIGN_EPI) { if (wr == 0) PG8_BAR; }
        E(acc, cur, wr, wc, fr, fq);
        if (!has_next) break;
#pragma unroll
        for (int a = 0; a < 2; ++a)
#pragma unroll
            for (int b = 0; b < 2; ++b)
#pragma unroll
                for (int m = 0; m < 4; ++m)
#pragma unroll
                    for (int n = 0; n < 2; ++n) acc[a][b][m][n] = (f32x4){0.f, 0.f, 0.f, 0.f};
        cur = nxt; cA = nA; cB = nB; ++ui;
        if constexpr (ALIGN_EPI) { if (wr == 1) PG8_BAR; }
    }
    PG8_WAIT_V(0);
    if constexpr (!ALIGN_EPI) { if (wr == 0) PG8_BAR; }
    PG8_BAR;
#undef PG8_SA
#undef PG8_SB
#undef PG8_STAGE
#undef PG8_LDA
#undef PG8_LDB
#undef PG8_MMA
#undef PG8_WAIT_V
#undef PG8_WAIT_L
#undef PG8_BAR
#undef PG8_SCHED
}
}

#define PG8_SP2 true
#define PG8_ALIGN true

constexpr int NWAVES = 8, NTHR = NWAVES * 64;
constexpr int N_LAUNCHES = MK_N_LAUNCHES;
constexpr int PER_PHASE = 12;
constexpr int D = 2048, MP = 8192, MS = 128, MR = MP + MS, MPAD = 8448;
constexpr int NPROJ = 14368, LDP = 14592, DFF = 8192, NMOD = 12288, DCAT = 4096;
constexpr int C_Q = 0, C_F = 2048, C_I = 4096, C_G = 6144, C_Z = 8192, C_X = 10240, C_DT = 14336;
constexpr int KS_IN = 8, KS_OUT = 16, KS_UP = 8, KS_DOWN = 32;
constexpr float EPS = 1e-6f;
constexpr size_t O_YP = 0, O_HP = 17039360, O_SP = 18087936, O_CP = 19136512, O_HS = 19185664, O_SS = 52740096, O_CS = 86294528, O_END = 87867392;

constexpr size_t MiB = 1u << 20;
constexpr size_t WS_CTL = 0, CTL_ZERO_BYTES = 1 * MiB;
constexpr size_t WS_WIN = 1 * MiB;
constexpr size_t WS_WOUT = 58 * MiB;
constexpr size_t WS_WUP = 74 * MiB;
constexpr size_t WS_WDOWN = 106 * MiB;
constexpr size_t WS_MOD = 138 * MiB;
constexpr size_t WS_HN = 145 * MiB;
constexpr size_t WS_PROJ = 178 * MiB;
constexpr size_t WS_RA = 414 * MiB;
constexpr size_t WS_SLABDT = WS_RA + 57 * MiB, WS_DTB = WS_RA + 65 * MiB;
constexpr size_t WS_RB = 481 * MiB;
constexpr size_t WS_RC = 546 * MiB;
constexpr size_t WS_XBC = 611 * MiB;
constexpr size_t WS_END = 675 * MiB;
constexpr size_t WS_SCCUM = WS_HN, WS_SCDT = WS_HN + 1 * MiB, WS_SCWS = WS_HN + 2 * MiB, WS_SCET = WS_HN + 3 * MiB, WS_SCEC = WS_HN + 4 * MiB, WS_ECB = WS_HN + 5 * MiB;
constexpr int CW_BAR = 4096, CW_Q = 8192;

constexpr int RING_BYTES = 131072, LDSCTL_OFF = RING_BYTES, MISC_OFF = LDSCTL_OFF + 320, LDS_BYTES = 147456;

#define GAS __attribute__((address_space(1)))
#define LAS __attribute__((address_space(3)))
typedef unsigned short bf16;
typedef unsigned v4u __attribute__((ext_vector_type(4)));
typedef unsigned v2u __attribute__((ext_vector_type(2)));
typedef float f32x4 __attribute__((ext_vector_type(4)));
typedef float f32x2 __attribute__((ext_vector_type(2)));
typedef short bf16x8 __attribute__((ext_vector_type(8)));
typedef GAS unsigned gu32;
#define RLX_AGENT __ATOMIC_RELAXED, __HIP_MEMORY_SCOPE_AGENT
#define LDS_WAIT() asm volatile("s_waitcnt lgkmcnt(0)" ::: "memory")
#define VM_WAIT() asm volatile("s_waitcnt vmcnt(0)" ::: "memory")
__device__ __forceinline__ unsigned f2bf(float f) { unsigned u = __builtin_bit_cast(unsigned, f); return (u + 0x7fffu + ((u >> 16) & 1u)) >> 16; }
__device__ __forceinline__ unsigned pk2(float lo, float hi) { return f2bf(lo) | (f2bf(hi) << 16); }
__device__ __forceinline__ float bflo(unsigned w) { return __builtin_bit_cast(float, w << 16); }
__device__ __forceinline__ float bfhi(unsigned w) { return __builtin_bit_cast(float, w & 0xffff0000u); }
__device__ __forceinline__ float bf1(bf16 h) { return __builtin_bit_cast(float, (unsigned)h << 16); }
__device__ __forceinline__ float sigmoidf_(float x) { return __builtin_amdgcn_rcpf(1.f + __expf(-x)); }
__device__ __forceinline__ float siluf_(float x) { return x * sigmoidf_(x); }
__device__ __forceinline__ float softplusf_(float x) { return fmaxf(x, 0.f) + log1pf(__expf(-fabsf(x))); }
__device__ __forceinline__ float wave_sum(float v) {
#pragma unroll
    for (int o = 1; o < 64; o <<= 1) v += __shfl_xor(v, o);
    return v;
}

#define XB_TMO      128
#define XB_XCNT(j)  (256  + 64 * (j))
#define XB_XSUB(j)  (1280 + 64 * (j))
#define XB_XGEN(j)  (2304 + 64 * (j))
#define XB_TOP      3328
#define XB_TOPGEN   3392
#define XCD_BAR_WORDS 3456
#define XB_SPIN_CAP (1u << 22)

__device__ __forceinline__ unsigned xb_ld(unsigned* p)              { return __hip_atomic_load(p, __ATOMIC_RELAXED, __HIP_MEMORY_SCOPE_AGENT); }
__device__ __forceinline__ unsigned xb_add(unsigned* p, unsigned v) { return __hip_atomic_fetch_add(p, v, __ATOMIC_RELAXED, __HIP_MEMORY_SCOPE_AGENT); }
__device__ __forceinline__ unsigned xb_xcc_id() { return (unsigned)__builtin_amdgcn_s_getreg((3 << 11) | 20) & 0xFu; }
#define XB_SPIN(cond, bar) do { unsigned _sp = 0; while (cond) { __builtin_amdgcn_s_sleep(1); \
    if ((++_sp & 255u) == 0u) { if (xb_ld(&(bar)[XB_TMO])) break; if (_sp > XB_SPIN_CAP) { atomicAdd(&(bar)[XB_TMO], 1u); break; } } } } while (0)

struct XcdBarrier { unsigned* bar; unsigned x; volatile LAS unsigned* st; };

__device__ __forceinline__ XcdBarrier xcd_barrier_post(unsigned* bar, volatile LAS unsigned* st) {
    XcdBarrier b; b.bar = bar; b.x = xb_xcc_id(); b.st = st;
    if (threadIdx.x == 0) (void)xb_add(&bar[XB_XCNT(b.x)], 1u);
    return b;
}
__device__ __forceinline__ void xcd_barrier_complete(unsigned* bar, unsigned x, unsigned& nloc, unsigned& nx) {
    const unsigned G = gridDim.x * gridDim.y * gridDim.z;
    unsigned sum, cnt, mine, sp = 0u;
    for (;;) {
        sum = 0u; cnt = 0u; mine = 0u;
#pragma unroll
        for (unsigned j = 0; j < 16; ++j) { const unsigned c = xb_ld(&bar[XB_XCNT(j)]); sum += c; cnt += (c > 0u) ? 1u : 0u; mine = (j == x) ? c : mine; }
        if (sum == G) break;
        __builtin_amdgcn_s_sleep(1);
        if ((++sp & 255u) == 0u) { if (xb_ld(&bar[XB_TMO])) break; if (sp > XB_SPIN_CAP) { atomicAdd(&bar[XB_TMO], 1u); break; } }
    }
    nloc = mine > 0u ? mine : 1u; nx = cnt > 0u ? cnt : 1u;
}
__device__ __forceinline__ void xcd_barrier(const XcdBarrier& b) {
    asm volatile("s_waitcnt vmcnt(0)" ::: "memory");
    __syncthreads();
    if (threadIdx.x == 0) {
        unsigned* bar = b.bar;
        __builtin_amdgcn_s_waitcnt(0);
        unsigned nloc = b.st[0], nx = b.st[1];
        if (nloc == 0u) { xcd_barrier_complete(bar, b.x, nloc, nx); b.st[0] = nloc; b.st[1] = nx; }
        const unsigned old = xb_add(&bar[XB_XSUB(b.x)], 1u);
        const unsigned gen = old / nloc;
        if (old + 1u == (gen + 1u) * nloc) {
            __builtin_amdgcn_fence(__ATOMIC_RELEASE, "agent");
            asm volatile("s_waitcnt vmcnt(0)" ::: "memory");
            const unsigned og = xb_add(&bar[XB_TOP], 1u);
            const unsigned tg = og / nx;
            if (og + 1u == (tg + 1u) * nx) xb_add(&bar[XB_TOPGEN], 1u);
            else XB_SPIN(xb_ld(&bar[XB_TOPGEN]) == tg, bar);
            __builtin_amdgcn_fence(__ATOMIC_ACQUIRE, "agent");
            xb_add(&bar[XB_XGEN(b.x)], 1u);
            asm volatile("s_waitcnt vmcnt(0)" ::: "memory");
        } else {
            XB_SPIN(xb_ld(&bar[XB_XGEN(b.x)]) == gen, bar);
            __builtin_amdgcn_fence(__ATOMIC_ACQUIRE, "agent");
            asm volatile("s_waitcnt vmcnt(0)" ::: "memory");
        }
    }
    __syncthreads();
}

struct Args { const float* in[25]; float* out; unsigned char* ws; int ph_lo, ph_hi; };
enum { I_XP = 0, I_XS, I_CP, I_CS, I_SH, I_SS, I_SC, I_WADA, I_BADA, I_GPREMIX, I_GPOSTMIX, I_GPREMLP, I_GPOSTMLP, I_WIN, I_LB, I_HNORM, I_CONVW, I_CONVB, I_DTB, I_ALOG, I_DSKIP, I_SNORM, I_WOUT, I_WUP, I_WDOWN };

__device__ __forceinline__ void p0_transpose_item(const float* W, int K, int N, bf16* WT, LAS float* scr, int item, int lane) {
    const int nblk = N / 32, kb = item / nblk, nb = item % nblk, k0 = 64 * kb, n0 = 32 * nb;
#pragma unroll 8
    for (int i = 0; i < 32; ++i) { const int kk = 2 * i + (lane >> 5); scr[kk * 33 + (lane & 31)] = W[(size_t)(k0 + kk) * N + n0 + (lane & 31)]; }
    LDS_WAIT(); asm volatile("" ::: "memory");
    const int c = lane & 7;
#pragma unroll
    for (int j = 0; j < 4; ++j) { const int n = (lane >> 3) + 8 * j; const LAS float* s = scr + (8 * c) * 33 + n;
        v4u o; o.x = pk2(s[0 * 33], s[1 * 33]); o.y = pk2(s[2 * 33], s[3 * 33]); o.z = pk2(s[4 * 33], s[5 * 33]); o.w = pk2(s[6 * 33], s[7 * 33]);
        *(GAS v4u*)(WT + (size_t)(n0 + n) * K + k0 + 8 * c) = o; }
    LDS_WAIT(); asm volatile("" ::: "memory");
}

__device__ __forceinline__ void p0_adaln_job(const float* cp, const float* cs, const float* wada, const float* bada, float* mod, LAS float* red, int job, int wave, int lane, int tid) {
    const int n0 = job * 48;
    f32x4 acc[9][3];
#pragma unroll
    for (int a = 0; a < 9; ++a)
#pragma unroll
        for (int b = 0; b < 3; ++b) acc[a][b] = (f32x4){0.f, 0.f, 0.f, 0.f};
    const int kq = 8 * (lane >> 4), lr = lane & 15;
#pragma unroll 1
    for (int ks = 0; ks < 8; ++ks) {
        const int kk = wave * 256 + ks * 32 + kq;
        bf16x8 bfr[3];
#pragma unroll
        for (int nt = 0; nt < 3; ++nt) {
            const float* wp = wada + (size_t)kk * NMOD + n0 + nt * 16 + lr;
            float w[8];
#pragma unroll
            for (int j = 0; j < 8; ++j) w[j] = wp[(size_t)j * NMOD];
            v4u p; p.x = pk2(w[0], w[1]); p.y = pk2(w[2], w[3]); p.z = pk2(w[4], w[5]); p.w = pk2(w[6], w[7]);
            bfr[nt] = __builtin_bit_cast(bf16x8, p);
        }
#pragma unroll
        for (int mt = 0; mt < 9; ++mt) {
            const int m = mt * 16 + lr;
            f32x4 c0 = (f32x4){0.f, 0.f, 0.f, 0.f}, c1 = c0;
            if (m < 132) { const float* src = (m < 4) ? (cp + (size_t)m * D) : (cs + (size_t)(m - 4) * D); c0 = *(const f32x4*)(src + kk); c1 = *(const f32x4*)(src + kk + 4); }
            v4u p; p.x = pk2(siluf_(c0[0]), siluf_(c0[1])); p.y = pk2(siluf_(c0[2]), siluf_(c0[3])); p.z = pk2(siluf_(c1[0]), siluf_(c1[1])); p.w = pk2(siluf_(c1[2]), siluf_(c1[3]));
            const bf16x8 afr = __builtin_bit_cast(bf16x8, p);
#pragma unroll
            for (int nt = 0; nt < 3; ++nt) acc[mt][nt] = __builtin_amdgcn_mfma_f32_16x16x32_bf16(afr, bfr[nt], acc[mt][nt], 0, 0, 0);
        }
    }
    for (int r = 0; r < 8; ++r) {
        if (wave == r) {
#pragma unroll
            for (int mt = 0; mt < 9; ++mt)
#pragma unroll
                for (int nt = 0; nt < 3; ++nt)
#pragma unroll
                    for (int i = 0; i < 4; ++i) { const int idx = (mt * 16 + (lane >> 4) * 4 + i) * 48 + nt * 16 + lr; const float prev = (r == 0) ? 0.f : red[idx]; red[idx] = prev + acc[mt][nt][i]; }
        }
        __syncthreads();
    }
    for (int idx = tid; idx < 132 * 48; idx += NTHR) { const int m = idx / 48, c = idx - m * 48; mod[(size_t)m * NMOD + n0 + c] = red[idx] + bada[n0 + c]; }
    __syncthreads();
}

typedef float f32x16 __attribute__((ext_vector_type(16)));
typedef float f32x2_t __attribute__((ext_vector_type(2)));
typedef __bf16 bf16x2_t __attribute__((ext_vector_type(2)));
#define MFMA32(a, b, c) __builtin_amdgcn_mfma_f32_32x32x16_bf16((a), (b), (c), 0, 0, 0)
__device__ __forceinline__ int crow16(int reg, int h) { return (reg & 3) + 8 * (reg >> 2) + 4 * h; }
__device__ __forceinline__ unsigned cvtpk(float lo, float hi) { f32x2_t v = {lo, hi}; bf16x2_t b = __builtin_convertvector(v, bf16x2_t); return __builtin_bit_cast(unsigned, b); }
__device__ __forceinline__ bf16x8 frag16(const LAS unsigned char* base, int row, int rs, int kbyte) { return *(const LAS bf16x8*)(base + row * rs + kbyte); }
__device__ __forceinline__ bf16x8 fragperm(const LAS unsigned char* base, int row, int rs, int s0) { const v2u lo = *(const LAS v2u*)(base + row * rs + s0 * 2), hi = *(const LAS v2u*)(base + row * rs + s0 * 2 + 16); return __builtin_bit_cast(bf16x8, (v4u){lo.x, lo.y, hi.x, hi.y}); }
__device__ __forceinline__ bf16x8 pack8(const f32x16& x, int s) { return __builtin_bit_cast(bf16x8, (v4u){cvtpk(x[8 * s], x[8 * s + 1]), cvtpk(x[8 * s + 2], x[8 * s + 3]), cvtpk(x[8 * s + 4], x[8 * s + 5]), cvtpk(x[8 * s + 6], x[8 * s + 7])}); }
#ifndef PROBE_PHASE
#define PROBE_PHASE -1
#endif
#ifndef PROBE_REPS
#define PROBE_REPS 2
#endif
__device__ __forceinline__ int probe_nrep(int n) { asm volatile("" : "+s"(n)); return n; }
__global__ void __launch_bounds__(NTHR, 2) hymba_fwd(Args args) {
    extern __shared__ __attribute__((aligned(16))) unsigned char lds_raw[];
    LAS unsigned char* lds = (LAS unsigned char*)lds_raw;
    LAS float* Lf = (LAS float*)lds;
    volatile LAS unsigned* MISC = (volatile LAS unsigned*)(lds + MISC_OFF);
    const int G = gridDim.x, bid = blockIdx.x;
#define PHASE_IDS() int tid_o = threadIdx.x; asm volatile("" : "+v"(tid_o)); const int tid = tid_o, lane = tid & 63, wave = __builtin_amdgcn_readfirstlane(tid >> 6), gw = bid * NWAVES + wave, NGW = G * NWAVES; (void)lane; (void)gw; (void)NGW
    typedef const __attribute__((address_space(4))) Args* kargs_t;
#define PHASE_ARGS() kargs_t ap = (kargs_t)__builtin_amdgcn_kernarg_segment_ptr(); asm volatile("" : "+s"(ap)); unsigned char* ws = ap->ws; float* out = ap->out; (void)out; \
    bf16* WIN_T = (bf16*)(ws + WS_WIN); bf16* WOUT_T = (bf16*)(ws + WS_WOUT); bf16* WUP_T = (bf16*)(ws + WS_WUP); bf16* WDOWN_T = (bf16*)(ws + WS_WDOWN); \
    float* MOD = (float*)(ws + WS_MOD); bf16* HN = (bf16*)(ws + WS_HN); bf16* PROJ = (bf16*)(ws + WS_PROJ); bf16* UB = (bf16*)(ws + WS_PROJ); \
    float* SLAB_IN = (float*)(ws + WS_RA); float* SLAB_DT = (float*)(ws + WS_SLABDT); float* DTB = (float*)(ws + WS_DTB); \
    bf16* CAT = (bf16*)(ws + WS_RA); float* SLAB_UP = (float*)(ws + WS_RA); \
    float* OA_RAW = (float*)(ws + WS_RB); float* MIX = (float*)(ws + WS_RB); float* MLP = (float*)(ws + WS_RB); \
    float* Y_RAW = (float*)(ws + WS_RC); float* SLAB_OUT = (float*)(ws + WS_RC); float* SLAB_DOWN = (float*)(ws + WS_RC); \
    (void)WIN_T; (void)WOUT_T; (void)WUP_T; (void)WDOWN_T; (void)MOD; (void)HN; (void)PROJ; (void)UB; (void)SLAB_IN; (void)SLAB_DT; (void)DTB; (void)CAT; (void)SLAB_UP; (void)OA_RAW; (void)MIX; (void)MLP; (void)Y_RAW; (void)SLAB_OUT; (void)SLAB_DOWN
#define AIN(i) ((const float*)ap->in[i])
    kargs_t ap0 = (kargs_t)__builtin_amdgcn_kernarg_segment_ptr();
    gu32* ctl = (gu32*)(ap0->ws + WS_CTL);

    for (int u = threadIdx.x; u < (LDS_BYTES - LDSCTL_OFF) / 4; u += NTHR) ((LAS unsigned*)(lds + LDSCTL_OFF))[u] = 0u;
    __syncthreads();
    XcdBarrier bar; bar.bar = (unsigned*)(ctl + CW_BAR); bar.x = 0; bar.st = nullptr;
    if (N_LAUNCHES != PER_PHASE) bar = xcd_barrier_post((unsigned*)(ctl + CW_BAR), MISC + 8);
    const int lo = ap0->ph_lo, hi = ap0->ph_hi;
#define IN(k) (lo <= (k) && (k) < hi)
#if PROBE_PHASE >= 0
#define REPLOOP(k) for (int rep_ = 0, nr_ = probe_nrep((k) == PROBE_PHASE ? PROBE_REPS : 1); rep_ < nr_; ++rep_)
#define P4REP rep_
#else
#define REPLOOP(k)
#define P4REP 0
#endif
#define SEAM(k) do { if (IN(k) && IN((k) + 1)) xcd_barrier(bar); } while (0)

    if (IN(0)) REPLOOP(0) {
        PHASE_ARGS();
        PHASE_IDS();
        for (int job = bid; job < 256; job += G)
            p0_adaln_job(AIN(I_CP), AIN(I_CS), AIN(I_WADA), AIN(I_BADA), MOD, Lf, job, wave, lane, tid);
        LAS float* scr = Lf + wave * 4096;
        constexpr int IT_IN = (D / 64) * (NPROJ / 32), IT_OUT = (DCAT / 64) * (D / 32), IT_UP = (D / 64) * (DFF / 32), IT_DOWN = (DFF / 64) * (D / 32);
        constexpr int NITEMS = IT_IN + IT_OUT + IT_UP + IT_DOWN;
        for (int it = gw; it < NITEMS; it += NGW) {
            int r = it;
            if (r < IT_IN) { p0_transpose_item(AIN(I_WIN), D, NPROJ, WIN_T, scr, r, lane); continue; } r -= IT_IN;
            if (r < IT_OUT) { p0_transpose_item(AIN(I_WOUT), DCAT, D, WOUT_T, scr, r, lane); continue; } r -= IT_OUT;
            if (r < IT_UP) { p0_transpose_item(AIN(I_WUP), D, DFF, WUP_T, scr, r, lane); continue; } r -= IT_UP;
            p0_transpose_item(AIN(I_WDOWN), DFF, D, WDOWN_T, scr, r, lane);
        }
        { v4u z = (v4u){0u, 0u, 0u, 0u}; GAS v4u* p = (GAS v4u*)(WIN_T + (size_t)NPROJ * D); const int n16 = (LDP - NPROJ) * D * 2 / 16;
          for (int i = bid * NTHR + tid; i < n16; i += G * NTHR) p[i] = z; }
    }
    SEAM(0);

    if (IN(1)) REPLOOP(1) {
        PHASE_ARGS();
        PHASE_IDS();
        const float* gpre = AIN(I_GPREMIX);
        for (int r = gw; r < MPAD; r += NGW) {
            GAS v2u* o8 = (GAS v2u*)(HN + (size_t)r * D) + lane;
            if (r >= MR) {
#pragma unroll
                for (int j = 0; j < 8; ++j) o8[64 * j] = (v2u){0u, 0u};
                continue; }
            const float* xr = (r < MP) ? AIN(I_XP) + (size_t)r * D : AIN(I_XS) + (size_t)(r - MP) * D;
            const float* mrow = MOD + (size_t)((r < MP) ? (r >> 11) : (4 + r - MP)) * NMOD;
            f32x4 v[8]; float ss = 0.f;
#pragma unroll
            for (int j = 0; j < 8; ++j) { v[j] = *((const f32x4*)xr + lane + 64 * j); ss += (v[j][0] * v[j][0] + v[j][1] * v[j][1]) + (v[j][2] * v[j][2] + v[j][3] * v[j][3]); }
            const float rinv = rsqrtf(wave_sum(ss) * (1.f / D) + EPS);
#pragma unroll
            for (int j = 0; j < 8; ++j) { const int c = 4 * lane + 256 * j;
                const f32x4 g = *(const f32x4*)(gpre + c), sh = *(const f32x4*)(mrow + c), sc = *(const f32x4*)(mrow + D + c);
                const f32x4 h = v[j] * rinv * g * (sc + 1.f) + sh;
                o8[64 * j] = (v2u){pk2(h[0], h[1]), pk2(h[2], h[3])}; }
        }
    }
    SEAM(1);

    if (IN(2)) REPLOOP(2) {
        PHASE_ARGS();
        { pg8::Gemm g{HN, WIN_T, D, D / 64}; pg8::FullOrder S; S.init(MP / 256, 56, G, bid);
          pg8::EpiBf16<0> E{PROJ, LDP};
          pg8::gemm_phase<pg8::EpiBf16<0>, pg8::FullOrder, PG8_ALIGN, PG8_SP2>(lds, g, S, E); }
        { pg8::Gemm g{HN, WIN_T, D, D / 64 / KS_IN}; pg8::SplitOrder S{32 * KS_IN, 56, 57 * KS_IN, 32, 3, G, bid};
          pg8::EpiSlab E{SLAB_IN, LDP, 32, SLAB_DT, MP};
          pg8::gemm_phase<pg8::EpiSlab, pg8::SplitOrder, PG8_ALIGN, PG8_SP2>(lds, g, S, E); }
    }
    SEAM(2);

    if (IN(3)) REPLOOP(3) {
        PHASE_ARGS();
        PHASE_IDS();
        float* SC_CUM = (float*)(ws + WS_SCCUM); float* SC_DT = (float*)(ws + WS_SCDT); float* SC_WS = (float*)(ws + WS_SCWS); float* SC_ET = (float*)(ws + WS_SCET); float* SC_EC = (float*)(ws + WS_SCEC); float* ECB = (float*)(ws + WS_ECB);
        bf16* XBC = (bf16*)(ws + WS_XBC);
        const int kp = lane, tq = wave;
        { const int n4 = MS * LDP / 4;
          for (int i = bid * NTHR + tid; i < n4; i += G * NTHR) {
              const int e = 4 * i, r = e / LDP, c = e - r * LDP;
              f32x4 sum = (f32x4){0.f, 0.f, 0.f, 0.f};
#pragma unroll
              for (int k = 0; k < KS_IN; ++k) sum += *(const f32x4*)(SLAB_IN + ((size_t)k * 128 + r) * LDP + c);
              *(GAS v2u*)(PROJ + (size_t)(MP + r) * LDP + c) = (v2u){pk2(sum[0], sum[1]), pk2(sum[2], sum[3])};
          }
          const float* dtb = AIN(I_DTB);
          for (int i = bid * NTHR + tid; i < MS * 32; i += G * NTHR) {
              const int row = i >> 5, h = i & 31; float sum = 0.f;
#pragma unroll
              for (int k = 0; k < KS_IN; ++k) sum += SLAB_IN[((size_t)k * 128 + row) * LDP + C_DT + h];
              DTB[MP * 32 + i] = softplusf_(sum + dtb[h]);
          } }
        { const float* lbl = AIN(I_LB); const int k0 = 2 * kp; int par = 0;
          for (int j = bid; j < 2048; j += G, par ^= 1) {
              const int cidx = j >> 4, h = j & 15; const size_t row0 = (size_t)cidx * 64;
              LAS float* TOT = Lf + par * 1024;
              const float lb0 = sigmoidf_(lbl[h * 128 + k0] - lbl[D + h * 128 + k0]), lb1 = sigmoidf_(lbl[h * 128 + k0 + 1] - lbl[D + h * 128 + k0 + 1]);
              GAS char* pq = (GAS char*)(PROJ + (row0 + 8 * tq) * LDP + h * 128);
              int lo = 4 * kp; asm volatile("" : "+v"(lo));
              unsigned qw[8], fw[8];
#pragma unroll
              for (int i = 0; i < 8; ++i) { qw[i] = *(const GAS unsigned*)(pq + (i * LDP + C_Q) * 2 + lo); fw[i] = *(const GAS unsigned*)(pq + (i * LDP + C_F) * 2 + lo); }
              float kk[2][8], cs[2][8];
#pragma unroll
              for (int e = 0; e < 2; ++e) { const float lb = e ? lb1 : lb0; float run = 0.f;
#pragma unroll
                  for (int i = 0; i < 8; ++i) { const float x = fmaxf(e ? bfhi(fw[i]) : bflo(fw[i]), -30.f); const float ex = __expf(-x), sg = __builtin_amdgcn_rcpf(1.f + ex);
                      const float f = lb + (1.f - lb) * sg; kk[e][i] = (1.f - lb) * ex * sg; run += __logf(f); cs[e][i] = run; }
                  TOT[tq * 128 + k0 + e] = run; }
              __syncthreads();
#pragma unroll
              for (int e = 0; e < 2; ++e) { float off = 0.f;
#pragma unroll
                  for (int q = 0; q < 7; ++q) off += (q < tq) ? TOT[q * 128 + k0 + e] : 0.f;
#pragma unroll
                  for (int i = 0; i < 8; ++i) cs[e][i] += off; }
#pragma unroll
              for (int i = 0; i < 8; ++i) { float qg[2], kg[2];
#pragma unroll
                  for (int e = 0; e < 2; ++e) { const float bb = cs[e][i], eb = __expf(bb), enb = __expf(-bb); const float qv = e ? bfhi(qw[i]) : bflo(qw[i]); qg[e] = siluf_(qv) * eb; kg[e] = kk[e][i] * enb; }
                  *(GAS unsigned*)(pq + (i * LDP + C_Q) * 2 + lo) = cvtpk(qg[0], qg[1]); *(GAS unsigned*)(pq + (i * LDP + C_F) * 2 + lo) = cvtpk(kg[0], kg[1]); }
              if (tq == 7) *(f32x2*)(ECB + (size_t)cidx * 2048 + h * 128 + k0) = (f32x2){__expf(cs[0][7]), __expf(cs[1][7])};
          } }
        { const float* convw = AIN(I_CONVW); const float* convb = AIN(I_CONVB);
          for (int j = bid; j < 4096; j += G) {
              const int cidx = j >> 5, cg = j & 31, col0 = cg * 128 + 2 * kp;
              float w[2][4], cb[2];
#pragma unroll
              for (int e = 0; e < 2; ++e) { cb[e] = convb[col0 + e];
#pragma unroll
                  for (int q = 0; q < 4; ++q) w[e][q] = convw[q * 4096 + col0 + e]; }
              const int tb = (cidx & 31) * 64 + 8 * tq - 3;
              int lo = 4 * kp; asm volatile("" : "+v"(lo));
              unsigned ux[11];
#pragma unroll
              for (int q = 0; q < 11; ++q) { const bool ok = (tb + q) >= 0; const GAS char* pr = (const GAS char*)(PROJ + ((size_t)cidx * 64 + 8 * tq - 3 + (ok ? q : 3)) * LDP + C_X + cg * 128);
                  ux[q] = *(const GAS unsigned*)(pr + lo); if (!ok) ux[q] = 0u; }
              GAS char* po = (GAS char*)(XBC + ((size_t)cidx * 64 + 8 * tq) * 4096 + cg * 128);
#pragma unroll
              for (int i = 0; i < 8; ++i) { float o[2];
#pragma unroll
                  for (int e = 0; e < 2; ++e) { float a = cb[e];
#pragma unroll
                      for (int q = 0; q < 4; ++q) a += w[e][q] * (e ? bfhi(ux[i + q]) : bflo(ux[i + q]));
                      o[e] = siluf_(a); }
                  *(GAS unsigned*)(po + i * 4096 * 2 + lo) = cvtpk(o[0], o[1]); }
          } }
        { const float* dtb = AIN(I_DTB); const float* alog = AIN(I_ALOG);
          for (int j = gw; j < 4096; j += NGW) {
              const int cidx = j >> 5, h = j & 31; const size_t row = (size_t)cidx * 64 + lane; float sum = 0.f;
#pragma unroll
              for (int k = 0; k < KS_IN; ++k) sum += SLAB_DT[((size_t)k * MP + row) * 32 + h];
              const float dt = softplusf_(sum + dtb[h]); float cum = dt * -__expf(alog[h]);
#pragma unroll
              for (int o = 1; o < 64; o <<= 1) { const float up = __shfl_up(cum, o); if (lane >= o) cum += up; }
              const float tot = __shfl(cum, 63);
              SC_CUM[(size_t)j * 64 + lane] = cum; SC_DT[(size_t)j * 64 + lane] = dt; SC_WS[(size_t)j * 64 + lane] = __expf(tot - cum) * dt; SC_ET[(size_t)j * 64 + lane] = __expf(cum);
              if (lane == 0) SC_EC[j] = __expf(tot);
          } }
    }
    SEAM(3);

    if (IN(4)) REPLOOP(4) {
        PHASE_ARGS();
        PHASE_IDS();
        const float* lbl = AIN(I_LB);
        const float* convw = AIN(I_CONVW); const float* convb = AIN(I_CONVB);
        const float* SC_CUM = (const float*)(ws + WS_SCCUM); const float* SC_DT = (const float*)(ws + WS_SCDT); const float* SC_WS = (const float*)(ws + WS_SCWS); const float* SC_ET = (const float*)(ws + WS_SCET); const float* SC_EC = (const float*)(ws + WS_SCEC); const float* ECB = (const float*)(ws + WS_ECB);
        const bf16* XBC = (const bf16*)(ws + WS_XBC);
        for (int rp_ = 0, nrp_ = probe_nrep(PROBE_PHASE == 40 ? PROBE_REPS : 1); rp_ < nrp_; ++rp_)
        for (int u = bid; u < 128; u += G) {
            const int r = lane & 31, lh = lane >> 5, tq = wave, kp = lane;
            const int tt = wave >> 2, ct = wave & 3;
            if (u < 64) {
                const int b = u >> 4, h = u & 15;
                LAS unsigned char* QG = lds; LAS unsigned char* KG = lds + 17408; LAS unsigned char* KGT = lds + 34816; LAS unsigned char* VT = lds + 53248; LAS unsigned char* ST = lds + 71680;
                LAS float* EC = (LAS float*)(lds + 106496);
                for (int i = tid; i < 34816 / 16; i += NTHR) ((LAS v4u*)ST)[i] = (v4u){0u, 0u, 0u, 0u};
                const int k0 = 2 * kp;
                const int kt = wave >> 1, vt0 = 2 * (wave & 1);
                f32x16 accS[2];
#pragma unroll
                for (int i = 0; i < 2; ++i)
#pragma unroll
                    for (int e = 0; e < 16; ++e) accS[i][e] = 0.f;
                unsigned qw[8], kw[8], vw[8]; f32x2 ecw = (f32x2){0.f, 0.f};
#define HG_LOAD(c0_) do { const GAS char* pq_ = (const GAS char*)(PROJ + ((size_t)b * 2048 + (c0_) + 8 * tq) * LDP + h * 128); int lo_ = 4 * kp; asm volatile("" : "+v"(lo_)); \
                    _Pragma("unroll") for (int i = 0; i < 8; ++i) { qw[i] = *(const GAS unsigned*)(pq_ + (i * LDP + C_Q) * 2 + lo_); kw[i] = *(const GAS unsigned*)(pq_ + (i * LDP + C_F) * 2 + lo_); vw[i] = *(const GAS unsigned*)(pq_ + (i * LDP + C_I) * 2 + lo_); } \
                    if (wave == 0) ecw = *(const f32x2*)(ECB + ((size_t)b * 32 + ((c0_) >> 6)) * 2048 + h * 128 + k0); } while (0)
                HG_LOAD(0);
                for (int c0 = 0; c0 < 2048; c0 += 64) {
                    const size_t row0 = (size_t)b * 2048 + c0;
#pragma unroll
                    for (int i = 0; i < 8; ++i) { *(LAS unsigned*)(QG + (8 * tq + i) * 272 + 4 * kp) = qw[i]; *(LAS unsigned*)(KG + (8 * tq + i) * 272 + 4 * kp) = kw[i]; }
                    *(LAS v4u*)(KGT + (k0) * 144 + 16 * tq) = (v4u){(kw[0] & 0xffffu) | (kw[1] << 16), (kw[2] & 0xffffu) | (kw[3] << 16), (kw[4] & 0xffffu) | (kw[5] << 16), (kw[6] & 0xffffu) | (kw[7] << 16)};
                    *(LAS v4u*)(KGT + (k0 + 1) * 144 + 16 * tq) = (v4u){(kw[0] >> 16) | (kw[1] & 0xffff0000u), (kw[2] >> 16) | (kw[3] & 0xffff0000u), (kw[4] >> 16) | (kw[5] & 0xffff0000u), (kw[6] >> 16) | (kw[7] & 0xffff0000u)};
                    *(LAS v4u*)(VT + (k0) * 144 + 16 * tq) = (v4u){(vw[0] & 0xffffu) | (vw[1] << 16), (vw[2] & 0xffffu) | (vw[3] << 16), (vw[4] & 0xffffu) | (vw[5] << 16), (vw[6] & 0xffffu) | (vw[7] << 16)};
                    *(LAS v4u*)(VT + (k0 + 1) * 144 + 16 * tq) = (v4u){(vw[0] >> 16) | (vw[1] & 0xffff0000u), (vw[2] >> 16) | (vw[3] & 0xffff0000u), (vw[4] >> 16) | (vw[5] & 0xffff0000u), (vw[6] >> 16) | (vw[7] & 0xffff0000u)};
                    if (wave == 0) *(LAS f32x2*)(EC + k0) = ecw;
                    __syncthreads();
                    if (c0 + 64 < 2048) HG_LOAD(c0 + 64);
                    { f32x16 Xd, Xf, O;
#pragma unroll
                      for (int e = 0; e < 16; ++e) { Xd[e] = 0.f; Xf[e] = 0.f; O[e] = 0.f; }
#pragma unroll
                      for (int ks = 0; ks < 8; ++ks) { const bf16x8 bq = frag16(QG, 32 * tt + r, 272, 32 * ks + 16 * lh), ad = frag16(KG, 32 * tt + r, 272, 32 * ks + 16 * lh);
                          Xd = MFMA32(ad, bq, Xd);
                          if (tt) { const bf16x8 af = frag16(KG, r, 272, 32 * ks + 16 * lh); Xf = MFMA32(af, bq, Xf); } }
#pragma unroll
                      for (int e = 0; e < 16; ++e) Xd[e] = (crow16(e, lh) <= r) ? Xd[e] : 0.f;
#pragma unroll
                      for (int st = 0; st < 2; ++st) { const bf16x8 xs = pack8(Xd, st); const bf16x8 bv = fragperm(VT, 32 * ct + r, 144, 32 * tt + 16 * st + 4 * lh); O = MFMA32(xs, bv, O); }
                      if (tt) {
#pragma unroll
                          for (int st = 0; st < 2; ++st) { const bf16x8 xs = pack8(Xf, st); const bf16x8 bv = fragperm(VT, 32 * ct + r, 144, 16 * st + 4 * lh); O = MFMA32(xs, bv, O); } }
#pragma unroll
                      for (int ks = 0; ks < 8; ++ks) { const bf16x8 a = frag16(QG, 32 * tt + r, 272, 32 * ks + 16 * lh), bs = frag16(ST, 32 * ct + r, 272, 32 * ks + 16 * lh); O = MFMA32(a, bs, O); }
                      GAS char* op = (GAS char*)(OA_RAW + (row0 + 32 * tt) * D + h * 128 + 32 * ct);
                      int lo = (4 * lh * D + r) * 4; asm volatile("" : "+v"(lo));
#pragma unroll
                      for (int e = 0; e < 16; ++e) *(GAS float*)(op + ((e & 3) + 8 * (e >> 2)) * D * 4 + lo) = O[e]; }
#pragma unroll
                    for (int i = 0; i < 2; ++i) {
#pragma unroll
                        for (int st = 0; st < 4; ++st) { const bf16x8 a = frag16(KGT, 32 * kt + r, 144, 32 * st + 16 * lh), bv = frag16(VT, 32 * (vt0 + i) + r, 144, 32 * st + 16 * lh); accS[i] = MFMA32(a, bv, accS[i]); }
#pragma unroll
                        for (int q = 0; q < 4; ++q) { const f32x4 e4 = *(const LAS f32x4*)(EC + 32 * kt + 8 * q + 4 * lh);
#pragma unroll
                            for (int j = 0; j < 4; ++j) accS[i][4 * q + j] *= e4[j]; } }
                    __syncthreads();
#pragma unroll
                    for (int i = 0; i < 2; ++i)
#pragma unroll
                        for (int q = 0; q < 4; ++q) *(LAS v2u*)(ST + (32 * (vt0 + i) + r) * 272 + (32 * kt + 8 * q + 4 * lh) * 2) = (v2u){cvtpk(accS[i][4 * q], accS[i][4 * q + 1]), cvtpk(accS[i][4 * q + 2], accS[i][4 * q + 3])};
                }
#undef HG_LOAD
#pragma unroll
                for (int i = 0; i < 2; ++i)
#pragma unroll
                    for (int e = 0; e < 16; ++e) out[O_HP + ((size_t)(b * 16 + h) * 128 + 32 * kt + crow16(e, lh)) * 128 + 32 * (vt0 + i) + r] = accS[i][e];
                __syncthreads();
            } else {
                const int uu = u - 64, b = uu >> 4, hp = uu & 15, h0 = 2 * hp, g = hp >> 1;
                LAS unsigned char* Cm = lds; LAS unsigned char* Bm = lds + 17408; LAS unsigned char* BmT = lds + 34816; LAS unsigned char* xT = lds + 53248; LAS unsigned char* xwT = lds + 71680; LAS unsigned char* Hb = lds + 90112;
                LAS float* CUM = (LAS float*)(lds + 124928); LAS float* DTv = (LAS float*)(lds + 125440); LAS float* ET = (LAS float*)(lds + 126464); LAS float* ECs = (LAS float*)(lds + 126976);
                for (int i = tid; i < 34816 / 16; i += NTHR) ((LAS v4u*)Hb)[i] = (v4u){0u, 0u, 0u, 0u};
                const int hh = ct >> 1, pt = ct & 1, hx = kp >> 5;
                const float dsk = AIN(I_DSKIP)[h0 + hh];
                const int nt = wave >> 1, hs_ = wave & 1;
                f32x16 accH[2];
#pragma unroll
                for (int i = 0; i < 2; ++i)
#pragma unroll
                    for (int e = 0; e < 16; ++e) accH[i][e] = 0.f;
                unsigned cw[8], bw[8], xw[8]; f32x4 wsa = (f32x4){0.f, 0.f, 0.f, 0.f}, wsb = wsa; float cumv = 0.f, dtv_ = 0.f, etv = 0.f, ecv = 0.f;
#define SS_LOAD(c0_) do { const GAS char* px_ = (const GAS char*)(XBC + ((size_t)b * 2048 + (c0_) + 8 * tq) * 4096); int lo_ = 4 * kp; asm volatile("" : "+v"(lo_)); const int cj_ = (b * 32 + ((c0_) >> 6)) * 32 + h0; \
                    _Pragma("unroll") for (int i = 0; i < 8; ++i) { xw[i] = *(const GAS unsigned*)(px_ + (i * 4096 + h0 * 64) * 2 + lo_); bw[i] = *(const GAS unsigned*)(px_ + (i * 4096 + 2048 + g * 128) * 2 + lo_); cw[i] = *(const GAS unsigned*)(px_ + (i * 4096 + 3072 + g * 128) * 2 + lo_); } \
                    wsa = *(const f32x4*)(SC_WS + (size_t)(cj_ + hx) * 64 + 8 * tq); wsb = *(const f32x4*)(SC_WS + (size_t)(cj_ + hx) * 64 + 8 * tq + 4); \
                    if (wave < 2) { cumv = SC_CUM[(size_t)(cj_ + wave) * 64 + lane]; dtv_ = SC_DT[(size_t)(cj_ + wave) * 64 + lane]; etv = SC_ET[(size_t)(cj_ + wave) * 64 + lane]; ecv = SC_EC[cj_ + wave]; } } while (0)
                SS_LOAD(0);
                for (int c0 = 0; c0 < 2048; c0 += 64) {
                    const size_t row0 = (size_t)b * 2048 + c0;
#pragma unroll
                    for (int i = 0; i < 8; ++i) { *(LAS unsigned*)(Bm + (8 * tq + i) * 272 + 4 * kp) = bw[i]; *(LAS unsigned*)(Cm + (8 * tq + i) * 272 + 4 * kp) = cw[i]; }
                    *(LAS v4u*)(BmT + (2 * kp) * 144 + 16 * tq) = (v4u){(bw[0] & 0xffffu) | (bw[1] << 16), (bw[2] & 0xffffu) | (bw[3] << 16), (bw[4] & 0xffffu) | (bw[5] << 16), (bw[6] & 0xffffu) | (bw[7] << 16)};
                    *(LAS v4u*)(BmT + (2 * kp + 1) * 144 + 16 * tq) = (v4u){(bw[0] >> 16) | (bw[1] & 0xffff0000u), (bw[2] >> 16) | (bw[3] & 0xffff0000u), (bw[4] >> 16) | (bw[5] & 0xffff0000u), (bw[6] >> 16) | (bw[7] & 0xffff0000u)};
                    *(LAS v4u*)(xT + (2 * kp) * 144 + 16 * tq) = (v4u){(xw[0] & 0xffffu) | (xw[1] << 16), (xw[2] & 0xffffu) | (xw[3] << 16), (xw[4] & 0xffffu) | (xw[5] << 16), (xw[6] & 0xffffu) | (xw[7] << 16)};
                    *(LAS v4u*)(xT + (2 * kp + 1) * 144 + 16 * tq) = (v4u){(xw[0] >> 16) | (xw[1] & 0xffff0000u), (xw[2] >> 16) | (xw[3] & 0xffff0000u), (xw[4] >> 16) | (xw[5] & 0xffff0000u), (xw[6] >> 16) | (xw[7] & 0xffff0000u)};
                    { const float wv[8] = {wsa[0], wsa[1], wsa[2], wsa[3], wsb[0], wsb[1], wsb[2], wsb[3]};
                      unsigned a0[4], a1[4];
#pragma unroll
                      for (int i = 0; i < 8; i += 2) { a0[i >> 1] = cvtpk(bflo(xw[i]) * wv[i], bflo(xw[i + 1]) * wv[i + 1]); a1[i >> 1] = cvtpk(bfhi(xw[i]) * wv[i], bfhi(xw[i + 1]) * wv[i + 1]); }
                      *(LAS v4u*)(xwT + (2 * kp) * 144 + 16 * tq) = (v4u){a0[0], a0[1], a0[2], a0[3]};
                      *(LAS v4u*)(xwT + (2 * kp + 1) * 144 + 16 * tq) = (v4u){a1[0], a1[1], a1[2], a1[3]}; }
                    if (wave < 2) { CUM[wave * 64 + lane] = cumv; DTv[wave * 64 + lane] = dtv_; ET[wave * 64 + lane] = etv; if (lane == 0) ECs[wave] = ecv; }
                    __syncthreads();
                    if (c0 + 64 < 2048) SS_LOAD(c0 + 64);
                    { f32x16 Xd, Xf, Y, Yi;
#pragma unroll
                      for (int e = 0; e < 16; ++e) { Xd[e] = 0.f; Xf[e] = 0.f; Y[e] = 0.f; Yi[e] = 0.f; }
#pragma unroll
                      for (int ks = 0; ks < 8; ++ks) { const bf16x8 bq = frag16(Cm, 32 * tt + r, 272, 32 * ks + 16 * lh), ad = frag16(Bm, 32 * tt + r, 272, 32 * ks + 16 * lh);
                          Xd = MFMA32(ad, bq, Xd);
                          if (tt) { const bf16x8 af = frag16(Bm, r, 272, 32 * ks + 16 * lh); Xf = MFMA32(af, bq, Xf); } }
                      const float cum_t = CUM[hh * 64 + 32 * tt + r];
#pragma unroll
                      for (int q = 0; q < 4; ++q) { const f32x4 c4 = *(const LAS f32x4*)(CUM + hh * 64 + 32 * tt + 8 * q + 4 * lh), d4 = *(const LAS f32x4*)(DTv + hh * 64 + 32 * tt + 8 * q + 4 * lh);
#pragma unroll
                          for (int j = 0; j < 4; ++j) { const int e = 4 * q + j; const float dec = __expf(fminf(cum_t - c4[j], 0.f)) * d4[j]; Xd[e] = (crow16(e, lh) <= r) ? Xd[e] * dec : 0.f; } }
#pragma unroll
                      for (int st = 0; st < 2; ++st) { const bf16x8 xs = pack8(Xd, st); const bf16x8 bv = fragperm(xT, hh * 64 + 32 * pt + r, 144, 32 * tt + 16 * st + 4 * lh); Y = MFMA32(xs, bv, Y); }
                      if (tt) {
#pragma unroll
                          for (int q = 0; q < 4; ++q) { const f32x4 c4 = *(const LAS f32x4*)(CUM + hh * 64 + 8 * q + 4 * lh), d4 = *(const LAS f32x4*)(DTv + hh * 64 + 8 * q + 4 * lh);
#pragma unroll
                              for (int j = 0; j < 4; ++j) { const int e = 4 * q + j; Xf[e] *= __expf(fminf(cum_t - c4[j], 0.f)) * d4[j]; } }
#pragma unroll
                          for (int st = 0; st < 2; ++st) { const bf16x8 xs = pack8(Xf, st); const bf16x8 bv = fragperm(xT, hh * 64 + 32 * pt + r, 144, 16 * st + 4 * lh); Y = MFMA32(xs, bv, Y); } }
#pragma unroll
                      for (int ks = 0; ks < 8; ++ks) { const bf16x8 a = frag16(Cm, 32 * tt + r, 272, 32 * ks + 16 * lh), bs = frag16(Hb, hh * 64 + 32 * pt + r, 272, 32 * ks + 16 * lh); Yi = MFMA32(a, bs, Yi); }
                      GAS char* yp = (GAS char*)(Y_RAW + (row0 + 32 * tt) * D + (h0 + hh) * 64 + 32 * pt);
                      int lo = (4 * lh * D + r) * 4; asm volatile("" : "+v"(lo));
#pragma unroll
                      for (int q = 0; q < 4; ++q) { const f32x4 e4 = *(const LAS f32x4*)(ET + hh * 64 + 32 * tt + 8 * q + 4 * lh);
                          const v2u xx = *(const LAS v2u*)(xT + (hh * 64 + 32 * pt + r) * 144 + (32 * tt + 8 * q + 4 * lh) * 2);
                          const float x4[4] = {bflo(xx.x), bfhi(xx.x), bflo(xx.y), bfhi(xx.y)};
#pragma unroll
                          for (int j = 0; j < 4; ++j) { const int e = 4 * q + j; *(GAS float*)(yp + (j + 8 * q) * D * 4 + lo) = Y[e] + e4[j] * Yi[e] + dsk * x4[j]; } } }
                    { const float ec = ECs[hs_];
#pragma unroll
                      for (int i = 0; i < 2; ++i) {
#pragma unroll
                          for (int e = 0; e < 16; ++e) accH[i][e] *= ec;
#pragma unroll
                          for (int st = 0; st < 4; ++st) { const bf16x8 a = frag16(BmT, 32 * nt + r, 144, 32 * st + 16 * lh), bv = frag16(xwT, hs_ * 64 + 32 * i + r, 144, 32 * st + 16 * lh); accH[i] = MFMA32(a, bv, accH[i]); } } }
                    __syncthreads();
#pragma unroll
                    for (int i = 0; i < 2; ++i)
#pragma unroll
                        for (int q = 0; q < 4; ++q) *(LAS v2u*)(Hb + (hs_ * 64 + 32 * i + r) * 272 + (32 * nt + 8 * q + 4 * lh) * 2) = (v2u){cvtpk(accH[i][4 * q], accH[i][4 * q + 1]), cvtpk(accH[i][4 * q + 2], accH[i][4 * q + 3])};
                }
#undef SS_LOAD
#pragma unroll
                for (int i = 0; i < 2; ++i)
#pragma unroll
                    for (int q = 0; q < 4; ++q) *(f32x4*)(out + O_SP + ((size_t)(b * 32 + h0 + hs_) * 64 + 32 * i + r) * 128 + 32 * nt + 8 * q + 4 * lh) = (f32x4){accH[i][4 * q], accH[i][4 * q + 1], accH[i][4 * q + 2], accH[i][4 * q + 3]};
                __syncthreads();
            }
        }
        const int NU = 512 + 2048 + 1024 + 12 + 384;
        for (;;) {
            if (tid == 0) MISC[0] = 512u + __hip_atomic_fetch_add((unsigned*)(ctl + CW_Q + 64 * P4REP), 1u, __ATOMIC_RELAXED, __HIP_MEMORY_SCOPE_AGENT);
            __syncthreads();
            const int u = (int)MISC[0];
            __syncthreads();
            if (u >= NU) break;
            if (u < 512) {
            } else if (u < 512 + 2048) {
                const int uu = u - 512, s = uu >> 4, h = uu & 15;
                LAS float* qv = Lf; LAS float* fv = Lf + 128; LAS float* kv = Lf + 256; LAS float* iv = Lf + 384; LAS float* red = Lf + 512;
                if (tid < 128) { const int c = h * 128 + tid; const bf16* pr = PROJ + (size_t)(MP + s) * LDP + c;
                    const float lb = sigmoidf_(lbl[c] - lbl[D + c]);
                    const float sg = sigmoidf_(bf1(pr[C_F]));
                    qv[tid] = siluf_(bf1(pr[C_Q])); fv[tid] = lb + (1.f - lb) * sg; kv[tid] = (1.f - lb) * (1.f - sg); iv[tid] = bf1(pr[C_I]); }
                __syncthreads();
                const int v4 = (tid & 31) * 4, kr = tid >> 5;
                const f32x4 i4 = *(const LAS f32x4*)(iv + v4);
                f32x4 o4 = (f32x4){0.f, 0.f, 0.f, 0.f};
                const size_t sb = ((size_t)(s * 16 + h) * 128) * 128 + v4;
                const float* S0 = AIN(I_SH) + sb; float* S1 = out + O_HS + sb;
                f32x4 sv[8];
#pragma unroll
                for (int i = 0; i < 8; ++i) sv[i] = *(const f32x4*)(S0 + (size_t)(kr + 16 * i) * 128);
#pragma unroll
                for (int i = 0; i < 8; ++i) { const int k = kr + 16 * i; const f32x4 nv = sv[i] * fv[k] + i4 * kv[k]; *(f32x4*)(S1 + (size_t)k * 128) = nv; o4 += nv * qv[k]; }
                *(LAS f32x4*)(red + kr * 128 + v4) = o4;
                __syncthreads();
                if (tid < 128) { float o = 0.f;
#pragma unroll
                    for (int r = 0; r < 16; ++r) o += red[r * 128 + tid];
                    OA_RAW[(size_t)(MP + s) * D + h * 128 + tid] = o; }
                __syncthreads();
            } else if (u < 512 + 2048 + 1024) {
                const int uu = u - 2560, s = uu >> 3, g = uu & 7;
                LAS float* xc = Lf; LAS float* Bc = Lf + 256; LAS float* Cc = Lf + 384; LAS float* dtv = Lf + 512; LAS float* dav = Lf + 516;
                { int col; LAS float* dst;
                  if (tid < 256) { col = g * 256 + tid; dst = xc + tid; } else if (tid < 384) { col = 2048 + g * 128 + (tid - 256); dst = Bc + (tid - 256); } else { col = 3072 + g * 128 + (tid - 384); dst = Cc + (tid - 384); }
                  const float* sc = AIN(I_SC) + (size_t)s * 3 * 4096 + col;
                  const float raw = bf1(PROJ[(size_t)(MP + s) * LDP + C_X + col]);
                  const float val = convb[col] + convw[col] * sc[0] + convw[4096 + col] * sc[4096] + convw[8192 + col] * sc[8192] + convw[12288 + col] * raw;
                  *dst = siluf_(val);
                  if (tid < 4) { const int h = 4 * g + tid; const float dt = DTB[(size_t)(MP + s) * 32 + h]; dtv[tid] = dt; dav[tid] = __expf(dt * -__expf(AIN(I_ALOG)[h])); } }
                __syncthreads();
                const int n4 = (tid & 31) * 4, pr_ = tid >> 5;
                const f32x4 B4 = *(const LAS f32x4*)(Bc + n4), C4 = *(const LAS f32x4*)(Cc + n4);
#pragma unroll
                for (int hh = 0; hh < 4; ++hh) {
                    const int h = 4 * g + hh; const float dt = dtv[hh], dA = dav[hh], dsk = AIN(I_DSKIP)[h];
                    const size_t sb = ((size_t)(s * 32 + h) * 64) * 128 + n4;
                    const float* H0 = AIN(I_SS) + sb; float* H1 = out + O_SS + sb;
                    f32x4 hv[4];
#pragma unroll
                    for (int i = 0; i < 4; ++i) hv[i] = *(const f32x4*)(H0 + (size_t)(pr_ + 16 * i) * 128);
#pragma unroll
                    for (int i = 0; i < 4; ++i) { const int p = pr_ + 16 * i; const float x = xc[hh * 64 + p]; const f32x4 nv = hv[i] * dA + B4 * (dt * x); *(f32x4*)(H1 + (size_t)p * 128) = nv;
                        const f32x4 yc = nv * C4; float y = (yc[0] + yc[1]) + (yc[2] + yc[3]);
                        y += __shfl_xor(y, 1); y += __shfl_xor(y, 2); y += __shfl_xor(y, 4); y += __shfl_xor(y, 8); y += __shfl_xor(y, 16);
                        if ((tid & 31) == 0) Y_RAW[(size_t)(MP + s) * D + h * 64 + p] = y + dsk * x; }
                }
                __syncthreads();
            } else if (u < 512 + 2048 + 1024 + 12) {
                const int uu = u - 3584, b = uu / 3, j = uu - 3 * b;
                for (int c = tid; c < 4096; c += NTHR) out[O_CP + (size_t)(b * 3 + j) * 4096 + c] = bf1(PROJ[((size_t)b * 2048 + 2045 + j) * LDP + C_X + c]);
            } else {
                const int uu = u - 3596, s = uu / 3, j = uu - 3 * s;
                for (int c = tid; c < 4096; c += NTHR) out[O_CS + (size_t)(s * 3 + j) * 4096 + c] = (j < 2) ? AIN(I_SC)[(size_t)(s * 3 + j + 1) * 4096 + c] : bf1(PROJ[(size_t)(MP + s) * LDP + C_X + c]);
            }
        }
    }
    SEAM(4);

    if (IN(5)) REPLOOP(5) {
        PHASE_ARGS();
        PHASE_IDS();
        const float* hnorm = AIN(I_HNORM); const float* snorm = AIN(I_SNORM);
        for (int r = gw; r < MPAD; r += NGW) {
            bf16* crow = CAT + (size_t)r * DCAT;
            if (r >= MR) {
#pragma unroll
                for (int j = 0; j < 8; ++j) *((GAS v4u*)crow + lane + 64 * j) = (v4u){0u, 0u, 0u, 0u};
                continue; }
            const bf16* prow = PROJ + (size_t)r * LDP;
#pragma unroll
            for (int j = 0; j < 8; ++j) { const int c = 4 * lane + 256 * j;
                const f32x4 o = *(const f32x4*)(OA_RAW + (size_t)r * D + c);
                float ss = (o[0] * o[0] + o[1] * o[1]) + (o[2] * o[2] + o[3] * o[3]);
                ss += __shfl_xor(ss, 1); ss += __shfl_xor(ss, 2); ss += __shfl_xor(ss, 4); ss += __shfl_xor(ss, 8); ss += __shfl_xor(ss, 16);
                const float rinv = rsqrtf(ss * (1.f / 128.f) + EPS);
                const v2u gg = *(const GAS v2u*)(prow + C_G + c); const f32x4 hn = *(const f32x4*)(hnorm + c);
                const float g0 = siluf_(bflo(gg.x)), g1 = siluf_(bfhi(gg.x)), g2 = siluf_(bflo(gg.y)), g3 = siluf_(bfhi(gg.y));
                *(GAS v2u*)(crow + c) = (v2u){pk2(o[0] * rinv * hn[0] * g0, o[1] * rinv * hn[1] * g1), pk2(o[2] * rinv * hn[2] * g2, o[3] * rinv * hn[3] * g3)}; }
#pragma unroll
            for (int j = 0; j < 8; ++j) { const int c = 4 * lane + 256 * j;
                const f32x4 y = *(const f32x4*)(Y_RAW + (size_t)r * D + c);
                const v2u zz = *(const GAS v2u*)(prow + C_Z + c); const f32x4 sn = *(const f32x4*)(snorm + c);
                const float a0 = y[0] * siluf_(bflo(zz.x)), a1 = y[1] * siluf_(bfhi(zz.x)), a2 = y[2] * siluf_(bflo(zz.y)), a3 = y[3] * siluf_(bfhi(zz.y));
                const float ss = wave_sum((a0 * a0 + a1 * a1) + (a2 * a2 + a3 * a3));
                const float rinv = rsqrtf(ss * (1.f / 256.f) + EPS);
                *(GAS v2u*)(crow + D + c) = (v2u){pk2(a0 * rinv * sn[0], a1 * rinv * sn[1]), pk2(a2 * rinv * sn[2], a3 * rinv * sn[3])}; }
        }
    }
    SEAM(5);

    if (IN(6)) REPLOOP(6) {
        PHASE_ARGS();
        { pg8::Gemm g{CAT, WOUT_T, DCAT, DCAT / 64}; pg8::FullOrder S; S.init(MP / 256, D / 256, G, bid);
          pg8::EpiF32 E{MIX, D};
          pg8::gemm_phase<pg8::EpiF32, pg8::FullOrder, PG8_ALIGN, PG8_SP2>(lds, g, S, E); }
        { pg8::Gemm g{CAT, WOUT_T, DCAT, DCAT / 64 / KS_OUT}; pg8::SplitOrder S{0, 0, (D / 256) * KS_OUT, 32, 4, G, bid};
          pg8::EpiSlab E{SLAB_OUT, D, 32, nullptr, 0};
          pg8::gemm_phase<pg8::EpiSlab, pg8::SplitOrder, PG8_ALIGN, PG8_SP2>(lds, g, S, E); }
    }
    SEAM(6);

    if (IN(7)) REPLOOP(7) {
        PHASE_ARGS();
        PHASE_IDS();
        const float* gpost = AIN(I_GPOSTMIX); const float* gpre = AIN(I_GPREMLP);
        for (int r = gw; r < MPAD; r += NGW) {
            GAS v2u* o8 = (GAS v2u*)(HN + (size_t)r * D) + lane;
            if (r >= MR) {
#pragma unroll
                for (int j = 0; j < 8; ++j) o8[64 * j] = (v2u){0u, 0u};
                continue; }
            const float* xr = (r < MP) ? AIN(I_XP) + (size_t)r * D : AIN(I_XS) + (size_t)(r - MP) * D;
            const float* mrow = MOD + (size_t)((r < MP) ? (r >> 11) : (4 + r - MP)) * NMOD;
            f32x4 v[8]; float ss = 0.f;
            if (r < MP) {
#pragma unroll
                for (int j = 0; j < 8; ++j) v[j] = *((const f32x4*)(MIX + (size_t)r * D) + lane + 64 * j);
            } else {
#pragma unroll
                for (int j = 0; j < 8; ++j) v[j] = (f32x4){0.f, 0.f, 0.f, 0.f};
#pragma unroll 1
                for (int k = 0; k < KS_OUT; ++k) { const f32x4* sp = (const f32x4*)(SLAB_OUT + ((size_t)k * 128 + (r - MP)) * D) + lane;
#pragma unroll
                    for (int j = 0; j < 8; ++j) v[j] += sp[64 * j]; }
            }
#pragma unroll
            for (int j = 0; j < 8; ++j) ss += (v[j][0] * v[j][0] + v[j][1] * v[j][1]) + (v[j][2] * v[j][2] + v[j][3] * v[j][3]);
            const float rinv = rsqrtf(wave_sum(ss) * (1.f / D) + EPS);
            float ss1 = 0.f;
#pragma unroll
            for (int j = 0; j < 8; ++j) { const int c = 4 * lane + 256 * j;
                const f32x4 x = *(const f32x4*)(xr + c), gp = *(const f32x4*)(gpost + c), gt = *(const f32x4*)(mrow + 2 * D + c);
                const f32x4 x1 = x + gt * (v[j] * rinv * gp);
                *(f32x4*)(out + O_YP + (size_t)r * D + c) = x1; v[j] = x1;
                ss1 += (x1[0] * x1[0] + x1[1] * x1[1]) + (x1[2] * x1[2] + x1[3] * x1[3]); }
            const float rinv1 = rsqrtf(wave_sum(ss1) * (1.f / D) + EPS);
#pragma unroll
            for (int j = 0; j < 8; ++j) { const int c = 4 * lane + 256 * j;
                const f32x4 g = *(const f32x4*)(gpre + c), sh = *(const f32x4*)(mrow + 3 * D + c), sc = *(const f32x4*)(mrow + 4 * D + c);
                const f32x4 h = v[j] * rinv1 * g * (sc + 1.f) + sh;
                o8[64 * j] = (v2u){pk2(h[0], h[1]), pk2(h[2], h[3])}; }
        }
    }
    SEAM(7);

    if (IN(8)) REPLOOP(8) {
        PHASE_ARGS();
        { pg8::Gemm g{HN, WUP_T, D, D / 64}; pg8::FullOrder S; S.init(MP / 256, DFF / 256, G, bid);
          pg8::EpiBf16<2> E{UB, DFF};
          pg8::gemm_phase<pg8::EpiBf16<2>, pg8::FullOrder, PG8_ALIGN, PG8_SP2>(lds, g, S, E); }
        { pg8::Gemm g{HN, WUP_T, D, D / 64 / KS_UP}; pg8::SplitOrder S{0, 0, (DFF / 256) * KS_UP, 32, 3, G, bid};
          pg8::EpiSlab E{SLAB_UP, DFF, 32, nullptr, 0};
          pg8::gemm_phase<pg8::EpiSlab, pg8::SplitOrder, PG8_ALIGN, PG8_SP2>(lds, g, S, E); }
    }
    SEAM(8);

    if (IN(9)) REPLOOP(9) {
        PHASE_ARGS();
        PHASE_IDS();
        const int n4 = MS * DFF / 4;
        for (int i = bid * NTHR + tid; i < 2 * n4; i += G * NTHR) {
            const int e = 4 * i, r = e / DFF, c = e - r * DFF;
            f32x4 s = (f32x4){0.f, 0.f, 0.f, 0.f};
            if (r < MS) {
#pragma unroll
                for (int k = 0; k < KS_UP; ++k) s += *(const f32x4*)(SLAB_UP + ((size_t)k * 128 + r) * DFF + c);
#pragma unroll
                for (int q = 0; q < 4; ++q) { const float a = fmaxf(s[q], 0.f); s[q] = a * a; }
            }
            *(GAS v2u*)(UB + (size_t)(MP + r) * DFF + c) = (v2u){pk2(s[0], s[1]), pk2(s[2], s[3])};
        }
    }
    SEAM(9);

    if (IN(10)) REPLOOP(10) {
        PHASE_ARGS();
        { pg8::Gemm g{UB, WDOWN_T, DFF, DFF / 64}; pg8::FullOrder S; S.init(MP / 256, D / 256, G, bid);
          pg8::EpiF32 E{MLP, D};
          pg8::gemm_phase<pg8::EpiF32, pg8::FullOrder, PG8_ALIGN, PG8_SP2>(lds, g, S, E); }
        { pg8::Gemm g{UB, WDOWN_T, DFF, DFF / 64 / KS_DOWN}; pg8::SplitOrder S{0, 0, (D / 256) * KS_DOWN, 32, 5, G, bid};
          pg8::EpiSlab E{SLAB_DOWN, D, 32, nullptr, 0};
          pg8::gemm_phase<pg8::EpiSlab, pg8::SplitOrder, PG8_ALIGN, PG8_SP2>(lds, g, S, E); }
    }
    SEAM(10);

    if (IN(11)) REPLOOP(11) {
        PHASE_ARGS();
        PHASE_IDS();
        const float* gpost = AIN(I_GPOSTMLP);
        for (int r = gw; r < MR; r += NGW) {
            const float* mrow = MOD + (size_t)((r < MP) ? (r >> 11) : (4 + r - MP)) * NMOD;
            f32x4 v[8]; float ss = 0.f;
            if (r < MP) {
#pragma unroll
                for (int j = 0; j < 8; ++j) v[j] = *((const f32x4*)(MLP + (size_t)r * D) + lane + 64 * j);
            } else {
#pragma unroll
                for (int j = 0; j < 8; ++j) v[j] = (f32x4){0.f, 0.f, 0.f, 0.f};
#pragma unroll 1
                for (int k = 0; k < KS_DOWN; ++k) { const f32x4* sp = (const f32x4*)(SLAB_DOWN + ((size_t)k * 128 + (r - MP)) * D) + lane;
#pragma unroll
                    for (int j = 0; j < 8; ++j) v[j] += sp[64 * j]; }
            }
#pragma unroll
            for (int j = 0; j < 8; ++j) ss += (v[j][0] * v[j][0] + v[j][1] * v[j][1]) + (v[j][2] * v[j][2] + v[j][3] * v[j][3]);
            const float rinv = rsqrtf(wave_sum(ss) * (1.f / D) + EPS);
#pragma unroll
            for (int j = 0; j < 8; ++j) { const int c = 4 * lane + 256 * j;
                float* yp = out + O_YP + (size_t)r * D + c;
                const f32x4 x1 = *(const f32x4*)yp, gp = *(const f32x4*)(gpost + c), gt = *(const f32x4*)(mrow + 5 * D + c);
                *(f32x4*)yp = x1 + gt * (v[j] * rinv * gp); }
        }
    }
#undef IN
#undef SEAM
}

extern "C" void kernel_launch(void* const* d_in, const int* in_sizes, int n_in, void* d_out, int out_size, void* d_ws, size_t ws_size, hipStream_t stream) {
    static int grid = 0;
    if (grid == 0) {
        if (n_in != 25 || (size_t)out_size != O_END || ws_size < WS_END) { fprintf(stderr, "kernel_launch: unexpected problem (n_in %d out %d ws %zu)\n", n_in, out_size, ws_size); grid = -1; return; }
        int dev = 0, cus = 0;
        if (hipGetDevice(&dev) != hipSuccess || hipDeviceGetAttribute(&cus, hipDeviceAttributeMultiprocessorCount, dev) != hipSuccess) { grid = -1; return; }
        if (hipFuncSetAttribute((const void*)hymba_fwd, hipFuncAttributeMaxDynamicSharedMemorySize, LDS_BYTES) != hipSuccess) { fprintf(stderr, "kernel_launch: hipFuncSetAttribute failed\n"); grid = -1; return; }
        int per_cu = 0;
        if (hipOccupancyMaxActiveBlocksPerMultiprocessor(&per_cu, (const void*)hymba_fwd, NTHR, LDS_BYTES) != hipSuccess || per_cu < 1) { fprintf(stderr, "kernel_launch: occupancy query says %d blocks per CU\n", per_cu); }
        (void)hipGetLastError();
        grid = cus;
    }
    if (grid < 0) return;
    if (hipMemsetAsync((char*)d_ws + WS_CTL, 0, CTL_ZERO_BYTES, stream) != hipSuccess) return;
    Args a{};
    for (int i = 0; i < 25; ++i) a.in[i] = (const float*)d_in[i];
    a.out = (float*)d_out; a.ws = (unsigned char*)d_ws;
    if (N_LAUNCHES == 1) {
        a.ph_lo = 0; a.ph_hi = PER_PHASE;
        hipLaunchKernelGGL(hymba_fwd, dim3(grid), dim3(NTHR), LDS_BYTES, stream, a);
    } else {
        for (int li = 0; li < PER_PHASE; ++li) { a.ph_lo = li; a.ph_hi = li + 1; hipLaunchKernelGGL(hymba_fwd, dim3(grid), dim3(NTHR), LDS_BYTES, stream, a); }
    }
}
```
